# Optimizing an MI355X kernel written in HIP

```python
import jax, jax.numpy as jnp
from jax import lax
import numpy as np

D_MODEL = 1024
BATCH = 2
SEQ = 8192
DEPTH = 2

CTX_LEN = 256
GRID_W = 64
HEAD_DIM = 64
N_HEADS = D_MODEL // HEAD_DIM
CONV_CH = D_MODEL // 2
FOURIER_CH = D_MODEL // 2
FOURIER_GROUP = 64
CONV_WIDTH = 3
WIN_ROWS = 8
WIN_COLS = 16
D_FF = 4 * D_MODEL
N_MOD = 6
EPS = 1e-6

kernel_name = "hybrid_conv_fourier_natten_dit_trunk"


def _rms(x, g):
    xf = x.astype(jnp.float32)
    y = xf * lax.rsqrt(jnp.mean(xf * xf, axis=-1, keepdims=True) + EPS)
    return y.astype(x.dtype) * g


def _modulate(h, shift, scale):
    return h * (1 + scale) + shift


def _conv3(z, w):
    zp = jnp.pad(z, ((0, 0), (1, 1), (0, 0)))
    return zp[:, :-2] * w[0] + zp[:, 1:-1] * w[1] + zp[:, 2:] * w[2]


def _conv_fourier_mixer(h, w_in, conv_w, w_out):
    b, L, _ = h.shape
    u = h @ w_in
    a_x, a_c, a_b, f = jnp.split(u, [CONV_CH, 2 * CONV_CH, 3 * CONV_CH], axis=-1)
    a_y = a_b * _conv3(a_c * a_x, conv_w)
    fg = f.reshape(b, L, FOURIER_CH // FOURIER_GROUP, FOURIER_GROUP).astype(jnp.float32)
    f_y = jnp.fft.fftn(fg, axes=(1, 3), norm="ortho").real
    f_y = f_y.reshape(b, L, FOURIER_CH).astype(h.dtype)
    return jnp.concatenate([a_y, f_y], axis=-1) @ w_out


def _heads(h, w, g=None):
    b, n, _ = h.shape
    t = (h @ w).reshape(b, n, -1, HEAD_DIM)
    return t if g is None else _rms(t, g)


def _neighbourhood_attention(q, k, v, k_ctx, v_ctx, rpb):
    b, n, h, d = q.shape
    rows = n // GRID_W
    kr = min(WIN_ROWS, rows)
    qg = q.reshape(b, rows, GRID_W, h, d)
    kg = k.reshape(b, rows, GRID_W, h, d)
    vg = v.reshape(b, rows, GRID_W, h, d)
    cols = jnp.arange(GRID_W)
    col_idx = jnp.clip(cols - WIN_COLS // 2, 0, GRID_W - WIN_COLS)[:, None] + jnp.arange(WIN_COLS)
    col_off = col_idx - cols[:, None] + (WIN_COLS - 1)
    bias_cols = rpb[:, :, col_off]
    scale = d ** -0.5
    n_loc = kr * WIN_COLS

    def row_block(r):
        rs = jnp.clip(r - kr // 2, 0, rows - kr)
        q_r = lax.dynamic_index_in_dim(qg, r, axis=1, keepdims=False)
        k_win = lax.dynamic_slice_in_dim(kg, rs, kr, axis=1)[:, :, col_idx]
        v_win = lax.dynamic_slice_in_dim(vg, rs, kr, axis=1)[:, :, col_idx]
        row_off = rs + jnp.arange(kr) - r + (WIN_ROWS - 1)
        bias = jnp.take(bias_cols, row_off, axis=1)
        s_loc = jnp.einsum('bwhd,brwchd->bhwrc', q_r, k_win).astype(jnp.float32) * scale
        s_loc = s_loc + jnp.transpose(bias, (0, 2, 1, 3)).astype(jnp.float32)[None]
        s_ctx = jnp.einsum('bwhd,bnhd->bhwn', q_r, k_ctx).astype(jnp.float32) * scale
        s = jnp.concatenate([s_loc.reshape(b, h, GRID_W, n_loc), s_ctx], axis=-1)
        p = jax.nn.softmax(s, axis=-1).astype(v.dtype)
        p_loc = p[..., :n_loc].reshape(b, h, GRID_W, kr, WIN_COLS)
        p_ctx = p[..., n_loc:]
        return (jnp.einsum('bhwrc,brwchd->bwhd', p_loc, v_win)
                + jnp.einsum('bhwn,bnhd->bwhd', p_ctx, v_ctx))

    o = lax.map(row_block, jnp.arange(rows))
    return jnp.moveaxis(o, 0, 1).reshape(b, n, h * d)


def _context_attention(q, k, v):
    b, n, h, d = q.shape
    s = jnp.einsum('bqhd,bkhd->bhqk', q, k).astype(jnp.float32) * (d ** -0.5)
    p = jax.nn.softmax(s, axis=-1).astype(v.dtype)
    return jnp.einsum('bhqk,bkhd->bqhd', p, v).reshape(b, n, h * d)


def _mlp(h, w1, w2):
    return jnp.square(jax.nn.relu(h @ w1)) @ w2


def setup_inputs(seed: int = 0) -> dict:
    key = jax.random.key(seed)
    ks = jax.random.split(key, 20)
    n_even = (DEPTH + 1) // 2
    n_odd = DEPTH // 2
    f32 = jnp.float32

    def nrm(k, shape, s):
        return jax.random.normal(k, shape, f32) * s

    return {
        "x": nrm(ks[0], (BATCH, SEQ, D_MODEL), 1.0),
        "c": nrm(ks[1], (BATCH, D_MODEL), 1.0),
        "ctx": nrm(ks[2], (BATCH, CTX_LEN, D_MODEL), 1.0),
        "c_ctx": nrm(ks[3], (D_MODEL,), 1.0),
        "ada_w": nrm(ks[4], (DEPTH, D_MODEL, N_MOD * D_MODEL), 0.5 * D_MODEL ** -0.5),
        "ada_b": nrm(ks[5], (DEPTH, N_MOD * D_MODEL), 0.02),
        "norm_mix_g": 1.0 + nrm(ks[6], (DEPTH, D_MODEL), 0.02),
        "norm_mlp_g": 1.0 + nrm(ks[7], (DEPTH, D_MODEL), 0.02),
        "mlp_w1": nrm(ks[8], (DEPTH, D_MODEL, D_FF), D_MODEL ** -0.5),
        "mlp_w2": nrm(ks[9], (DEPTH, D_FF, D_MODEL), D_FF ** -0.5),
        "ab_w_in": nrm(ks[10], (n_even, D_MODEL, 3 * CONV_CH + FOURIER_CH), D_MODEL ** -0.5),
        "ab_conv_w": nrm(ks[11], (n_even, CONV_WIDTH, CONV_CH), CONV_WIDTH ** -0.5),
        "ab_w_out": nrm(ks[12], (n_even, CONV_CH + FOURIER_CH, D_MODEL), (CONV_CH + FOURIER_CH) ** -0.5),
        "na_w_qkv": nrm(ks[13], (n_odd, D_MODEL, 3 * N_HEADS * HEAD_DIM), D_MODEL ** -0.5),
        "na_q_g": 1.0 + nrm(ks[14], (n_odd, HEAD_DIM), 0.02),
        "na_k_g": 1.0 + nrm(ks[15], (n_odd, HEAD_DIM), 0.02),
        "na_rpb": nrm(ks[16], (n_odd, N_HEADS, 2 * WIN_ROWS - 1, 2 * WIN_COLS - 1), 0.1),
        "na_w_out": nrm(ks[17], (n_odd, N_HEADS * HEAD_DIM, D_MODEL), (N_HEADS * HEAD_DIM) ** -0.5),
    }


def reference(x, c, ctx, c_ctx, ada_w, ada_b, norm_mix_g, norm_mlp_g, mlp_w1, mlp_w2,
              ab_w_in, ab_conv_w, ab_w_out, na_w_qkv, na_q_g, na_k_g, na_rpb, na_w_out):
    hd = N_HEADS * HEAD_DIM
    cond_x = jax.nn.silu(c)
    cond_c = jax.nn.silu(c_ctx)[None]
    for i in range(DEPTH):
        last = i == DEPTH - 1
        j = i // 2
        sx1, cx1, gx1, sx2, cx2, gx2 = jnp.split((cond_x @ ada_w[i] + ada_b[i])[:, None, :], N_MOD, axis=-1)
        sc1, cc1, gc1, sc2, cc2, gc2 = jnp.split((cond_c @ ada_w[i] + ada_b[i])[:, None, :], N_MOD, axis=-1)
        hx = _modulate(_rms(x, norm_mix_g[i]), sx1, cx1)
        if i % 2 == 0:
            x = x + gx1 * _conv_fourier_mixer(hx, ab_w_in[j], ab_conv_w[j], ab_w_out[j])
            if not last:
                hc = _modulate(_rms(ctx, norm_mix_g[i]), sc1, cc1)
                ctx = ctx + gc1 * _conv_fourier_mixer(hc, ab_w_in[j], ab_conv_w[j], ab_w_out[j])
        else:
            w = na_w_qkv[j]
            hc = _modulate(_rms(ctx, norm_mix_g[i]), sc1, cc1)
            q = _heads(hx, w[:, :hd], na_q_g[j])
            k = _heads(hx, w[:, hd:2 * hd], na_k_g[j])
            v = _heads(hx, w[:, 2 * hd:])
            k_c = _heads(hc, w[:, hd:2 * hd], na_k_g[j])
            v_c = _heads(hc, w[:, 2 * hd:])
            x = x + gx1 * (_neighbourhood_attention(q, k, v, k_c, v_c, na_rpb[j]) @ na_w_out[j])
            if not last:
                q_c = _heads(hc, w[:, :hd], na_q_g[j])
                ctx = ctx + gc1 * (_context_attention(q_c, k_c, v_c) @ na_w_out[j])
        x = x + gx2 * _mlp(_modulate(_rms(x, norm_mlp_g[i]), sx2, cx2), mlp_w1[i], mlp_w2[i])
        if not last:
            ctx = ctx + gc2 * _mlp(_modulate(_rms(ctx, norm_mlp_g[i]), sc2, cc2), mlp_w1[i], mlp_w2[i])
    return x
```

```cpp
#include <hip/hip_runtime.h>
#include <cstdio>
#include <cstdint>
namespace pg8 {
#define PG8_LAS __attribute__((address_space(3)))
typedef unsigned short bf16_t;
typedef short bf16x8 __attribute__((ext_vector_type(8)));
typedef float f32x4 __attribute__((ext_vector_type(4)));
typedef unsigned u32x4 __attribute__((ext_vector_type(4)));
constexpr int BM = 256, BK = 64, HALF = 128, HTB = HALF * BK * 2  , STAGE_BYTES = 8 * HTB, NXCD = 8, WGM = 8;

__host__ __device__ __forceinline__ int lds_byte(int r, int c) { const int st = (r >> 4) * 2 + (c >> 5), rr = r & 15, cc = c & 31, ob = rr * 64 + cc * 2; return st * 1024 + (ob ^ (((ob >> 9) & 1) << 5)); }
__host__ __device__ __forceinline__ void stage_rc(int b, int& R, int& C) { const int st = b / 1024, sb = b % 1024, swz = sb ^ (((sb >> 9) & 1) << 5); R = (st >> 1) * 16 + swz / 64; C = (st & 1) * 32 + (swz % 64) / 2; }
__host__ __device__ __forceinline__ int perm32(int rho) { const int n = rho >> 4, i = rho & 15; return 8 * (i >> 2) + 4 * n + (i & 3); }

struct Unit { int pm, pn; };
struct Gemm { const bf16_t* A; const bf16_t* Bt; int M, N, K; };

struct StaticOrder {
    int nM, nN, nwg, G, c;
    __host__ __device__ void init(int M, int N, int G_, int c_) { nM = M / BM; nN = N / BM; nwg = nM * nN; G = G_; c = c_; }
    __host__ __device__ bool next(int i, Unit& u) const {
        const long L = (long)i * G + c; if (L >= nwg) return false;
        int wgid = (int)L; { const int q = nwg / NXCD, r = nwg % NXCD, xcd = wgid % NXCD, off = wgid / NXCD; wgid = (xcd < r ? xcd * (q + 1) : r * (q + 1) + (xcd - r) * q) + off; }
        const int nig = WGM * nN, gid = wgid / nig, fm = gid * WGM, gsz = (nM - fm) < WGM ? (nM - fm) : WGM;
        u.pm = fm + ((wgid % nig) % gsz); u.pn = (wgid % nig) / gsz; return true;
    }
    __device__ __forceinline__ void a_ready(const Unit&) const {}
    __device__ __forceinline__ void done(const Unit&) const {}
};

__device__ __forceinline__ unsigned cvt_pk_bf16(float lo, float hi) { unsigned r; asm volatile("v_cvt_pk_bf16_f32 %0, %1, %2" : "=v"(r) : "v"(lo), "v"(hi)); return r; }
typedef float f32x2 __attribute__((ext_vector_type(2)));
typedef unsigned u32x2 __attribute__((ext_vector_type(2)));
struct EpiWin {
    static constexpr bool PERM = false, AFTER_DRAIN = false;
    bf16_t *PB, *AB, *FB;
    __device__ __forceinline__ void operator()(const f32x4 (&acc)[2][2][4][2], const Unit& u, int wr, int wc, int fr, int fq) const {
        const int ch0 = u.pn * 64 + wc * 16 + fq * 4;
#pragma unroll
        for (int ai = 0; ai < 2; ++ai)
#pragma unroll
            for (int m = 0; m < 4; ++m) {
                const size_t off = (size_t)(u.pm * BM + ai * HALF + wr * 64 + m * 16 + fr) * 512 + ch0;
                const f32x4 p = acc[ai][0][m][0] * acc[ai][0][m][1], ab = acc[ai][1][m][0], ff = acc[ai][1][m][1];
                u32x2 w; w.x = cvt_pk_bf16(p[0], p[1]); w.y = cvt_pk_bf16(p[2], p[3]); *(u32x2*)(PB + off) = w;
                w.x = cvt_pk_bf16(ab[0], ab[1]); w.y = cvt_pk_bf16(ab[2], ab[3]); *(u32x2*)(AB + off) = w;
                w.x = cvt_pk_bf16(ff[0], ff[1]); w.y = cvt_pk_bf16(ff[2], ff[3]); *(u32x2*)(FB + off) = w;
            }
    }
};
struct EpiRes {
    static constexpr bool PERM = false, AFTER_DRAIN = false;
    const float* rin_lat; const float* rin_ctx; float* out_lat; float* out_ctx; const float* gate;
    __device__ __forceinline__ void operator()(const f32x4 (&acc)[2][2][4][2], const Unit& u, int wr, int wc, int fr, int fq) const {
        const int col0 = u.pn * BM + wc * 32 + 4 * fq;
        const int grp = u.pm < 32 ? 0 : (u.pm < 64 ? 1 : 2);
        const float* gp = gate + grp * 6144 + col0;
        const bool lat = u.pm < 64;
        const float* ri = lat ? rin_lat + (size_t)u.pm * BM * 1024 : rin_ctx + (size_t)(u.pm - 64) * BM * 1024;
        float* ro = lat ? out_lat + (size_t)u.pm * BM * 1024 : out_ctx + (size_t)(u.pm - 64) * BM * 1024;
        f32x4 gv[2][2];
#pragma unroll
        for (int bj = 0; bj < 2; ++bj)
#pragma unroll
            for (int n = 0; n < 2; ++n) gv[bj][n] = *(const f32x4*)(gp + bj * HALF + n * 16);
#pragma unroll
        for (int ai = 0; ai < 2; ++ai)
#pragma unroll
            for (int m = 0; m < 4; ++m) { const size_t off = (size_t)(ai * HALF + wr * 64 + m * 16 + fr) * 1024 + col0;
#pragma unroll
                for (int bj = 0; bj < 2; ++bj)
#pragma unroll
                    for (int n = 0; n < 2; ++n) { const f32x4 r = *(const f32x4*)(ri + off + bj * HALF + n * 16); *(f32x4*)(ro + off + bj * HALF + n * 16) = r + gv[bj][n] * acc[ai][bj][m][n]; } }
    }
};
struct EpiRelu2 {
    static constexpr bool PERM = true, AFTER_DRAIN = false;
    bf16_t* O; int ldc;
    __device__ __forceinline__ void operator()(const f32x4 (&acc)[2][2][4][2], const Unit& u, int wr, int wc, int fr, int fq) const {
        const int row0 = u.pm * BM + wr * 64 + fr, col0 = u.pn * BM + wc * 32 + 8 * fq;
#pragma unroll
        for (int ai = 0; ai < 2; ++ai)
#pragma unroll
            for (int m = 0; m < 4; ++m) { bf16_t* rowp = O + (size_t)(row0 + ai * HALF + m * 16) * ldc + col0;
#pragma unroll
                for (int bj = 0; bj < 2; ++bj) { f32x4 v0 = acc[ai][bj][m][0], v1 = acc[ai][bj][m][1];
#pragma unroll
                    for (int e = 0; e < 4; ++e) { const float a = fmaxf(v0[e], 0.f), b = fmaxf(v1[e], 0.f); v0[e] = a * a; v1[e] = b * b; }
                    u32x4 w; w.x = cvt_pk_bf16(v0[0], v0[1]); w.y = cvt_pk_bf16(v0[2], v0[3]); w.z = cvt_pk_bf16(v1[0], v1[1]); w.w = cvt_pk_bf16(v1[2], v1[3]);
                    *(u32x4*)(rowp + bj * HALF) = w; } }
    }
};
struct EpiQkv {
    static constexpr bool PERM = true, AFTER_DRAIN = false;
    bf16_t* QKV; size_t part_stride; const float* gains;
    __device__ __forceinline__ void operator()(const f32x4 (&acc)[2][2][4][2], const Unit& u, int wr, int wc, int fr, int fq) const {
        const int part = u.pn >> 2, head = (u.pn & 3) * 4 + wc;
        bf16_t* base = QKV + (size_t)part * part_stride + head * 64 + 8 * fq;
        const bool nrm = part < 2;
        f32x4 gn[2][2];
#pragma unroll
        for (int bj = 0; bj < 2; ++bj)
#pragma unroll
            for (int n = 0; n < 2; ++n) gn[bj][n] = *(const f32x4*)(gains + (part & 1) * 64 + 32 * bj + 8 * fq + 4 * n);
#pragma unroll
        for (int ai = 0; ai < 2; ++ai)
#pragma unroll
            for (int m = 0; m < 4; ++m) {
                f32x4 v[2][2];
#pragma unroll
                for (int bj = 0; bj < 2; ++bj)
#pragma unroll
                    for (int n = 0; n < 2; ++n) v[bj][n] = acc[ai][bj][m][n];
                float ss = 0.f;
#pragma unroll
                for (int bj = 0; bj < 2; ++bj)
#pragma unroll
                    for (int n = 0; n < 2; ++n) ss += (v[bj][n][0] * v[bj][n][0] + v[bj][n][1] * v[bj][n][1]) + (v[bj][n][2] * v[bj][n][2] + v[bj][n][3] * v[bj][n][3]);
                ss += __shfl_xor(ss, 16); ss += __shfl_xor(ss, 32);
                const float rstd = rsqrtf(ss * (1.0f / 64.0f) + 1e-6f);
#pragma unroll
                for (int bj = 0; bj < 2; ++bj)
#pragma unroll
                    for (int n = 0; n < 2; ++n) { const f32x4 t = v[bj][n] * rstd * gn[bj][n]; v[bj][n] = nrm ? t : v[bj][n]; }
                bf16_t* rowp = base + (size_t)(u.pm * BM + ai * HALF + wr * 64 + m * 16 + fr) * 1024;
#pragma unroll
                for (int bj = 0; bj < 2; ++bj) { u32x4 w; w.x = cvt_pk_bf16(v[bj][0][0], v[bj][0][1]); w.y = cvt_pk_bf16(v[bj][0][2], v[bj][0][3]); w.z = cvt_pk_bf16(v[bj][1][0], v[bj][1][1]); w.w = cvt_pk_bf16(v[bj][1][2], v[bj][1][3]);
                    *(u32x4*)(rowp + 32 * bj) = w; }
            }
    }
};
template <class Epi, class Sched, bool ALIGN_EPI = false, bool SP2 = false>
__device__ __forceinline__ void gemm_phase(PG8_LAS unsigned char* lds, const Gemm g, const Sched& S, const Epi& E) {
    const int tid = threadIdx.x, wid = __builtin_amdgcn_readfirstlane(tid >> 6), lane = tid & 63, wr = wid >> 2, wc = wid & 3, fr = lane & 15, fq = lane >> 4;
    const int K = g.K, nt = K / BK;
    unsigned voffA[2], voffB[2];
#pragma unroll
    for (int i = 0; i < 2; ++i) { int R, C; stage_rc(tid * 16 + i * 8192, R, C); const int Rb = Epi::PERM ? ((R & ~31) + perm32(R & 31)) : R;
        voffA[i] = (unsigned)(R * K + C) * 2u; voffB[i] = (unsigned)(Rb * K + C) * 2u; }
    const size_t kstep = (size_t)(BK * 2);
    const size_t hstep = (size_t)HALF * K * 2;
    const size_t tstep = 2 * hstep;
    const unsigned ldsw = (unsigned)wid * 1024u;
    const int aoff = lds_byte(wr * 64 + fr, fq * 8), boff = lds_byte(wc * 32 + fr, fq * 8);
#define PG8_SA(b, h) (((b) * 2 + (h)) * HTB)
#define PG8_SB(b, h) ((4 + (b) * 2 + (h)) * HTB)
#define PG8_STAGE(bufoff, gbase, voff) do { _Pragma("unroll") for (int _i = 0; _i < 2; ++_i) \
        __builtin_amdgcn_global_load_lds((const unsigned*)((const char*)(gbase) + (voff)[_i]), (PG8_LAS unsigned*)(lds + (bufoff) + ldsw + _i * 8192), 16, 0, 0); } while (0)
#define PG8_LDA(dst, b, h) do { _Pragma("unroll") for (int m = 0; m < 4; ++m) _Pragma("unroll") for (int k = 0; k < 2; ++k) dst[m][k] = *(const PG8_LAS bf16x8*)(lds + PG8_SA(b, h) + aoff + m * 2048 + k * 1024); } while (0)
#define PG8_LDB(dst, b, h) do { _Pragma("unroll") for (int n = 0; n < 2; ++n) _Pragma("unroll") for (int k = 0; k < 2; ++k) dst[n][k] = *(const PG8_LAS bf16x8*)(lds + PG8_SB(b, h) + boff + n * 2048 + k * 1024); } while (0)
#define PG8_MMA(ai, bj, At, Bt) do { __builtin_amdgcn_s_setprio(1); _Pragma("unroll") for (int m = 0; m < 4; ++m) _Pragma("unroll") for (int n = 0; n < 2; ++n) _Pragma("unroll") for (int k = 0; k < 2; ++k) \
        acc[ai][bj][m][n] = __builtin_amdgcn_mfma_f32_16x16x32_bf16(Bt[n][k], At[m][k], acc[ai][bj][m][n], 0, 0, 0); __builtin_amdgcn_s_setprio(0); } while (0)
#define PG8_WAIT_V(n) asm volatile("s_waitcnt vmcnt(" #n ")" ::: "memory")
#define PG8_WAIT_L(n) asm volatile("s_waitcnt lgkmcnt(" #n ")" ::: "memory")
#define PG8_BAR __builtin_amdgcn_s_barrier()
#define PG8_SCHED __builtin_amdgcn_sched_barrier(0)
    Unit cur, nxt; int ui = 0;
    if (!S.next(0, cur)) return;
    f32x4 acc[2][2][4][2];
#pragma unroll
    for (int a = 0; a < 2; ++a)
#pragma unroll
        for (int b = 0; b < 2; ++b)
#pragma unroll
            for (int m = 0; m < 4; ++m)
#pragma unroll
                for (int n = 0; n < 2; ++n) acc[a][b][m][n] = (f32x4){0.f, 0.f, 0.f, 0.f};
    bf16x8 At[4][2], B0[2][2], B1[2][2];
    const char* cA = (const char*)g.A + (size_t)cur.pm * tstep; const char* cB = (const char*)g.Bt + (size_t)cur.pn * tstep;
    S.a_ready(cur);
    if constexpr (SP2) {
        PG8_STAGE(PG8_SB(0, 0), cB, voffB); PG8_STAGE(PG8_SB(0, 1), cB + hstep, voffB); PG8_STAGE(PG8_SA(0, 0), cA, voffA); PG8_STAGE(PG8_SA(0, 1), cA + hstep, voffA);
        if (wr == 1) PG8_BAR;
        PG8_WAIT_V(2); PG8_BAR;
        PG8_STAGE(PG8_SB(1, 0), cB + kstep, voffB); PG8_STAGE(PG8_SA(1, 0), cA + kstep, voffA); PG8_STAGE(PG8_SB(1, 1), cB + hstep + kstep, voffB);
        PG8_WAIT_V(6); PG8_BAR;
    } else {
        PG8_STAGE(PG8_SB(0, 0), cB, voffB); PG8_STAGE(PG8_SA(0, 0), cA, voffA); PG8_STAGE(PG8_SB(0, 1), cB + hstep, voffB); PG8_STAGE(PG8_SA(0, 1), cA + hstep, voffA);
        if (wr == 1) PG8_BAR;
        PG8_WAIT_V(4); PG8_BAR;
        PG8_STAGE(PG8_SB(1, 0), cB + kstep, voffB); PG8_STAGE(PG8_SA(1, 0), cA + kstep, voffA); PG8_STAGE(PG8_SB(1, 1), cB + hstep + kstep, voffB);
        PG8_WAIT_V(6); PG8_BAR;
    }
    for (;;) {
        const bool has_next = S.next(ui + 1, nxt);
        const char* nA = has_next ? (const char*)g.A + (size_t)nxt.pm * tstep : cA; const char* nB = has_next ? (const char*)g.Bt + (size_t)nxt.pn * tstep : cB;
        for (int t = 0; t < nt; t += 2) {
            const bool last = (t == nt - 2);
            const char* a1 = cA + (size_t)(t + 1) * kstep;
            const char* a2 = last ? nA : cA + (size_t)(t + 2) * kstep; const char* b2 = last ? nB : cB + (size_t)(t + 2) * kstep;
            const char* a3 = a2 + kstep; const char* b3 = b2 + kstep;
            if (last && has_next) S.a_ready(nxt);
            if constexpr (SP2) {
            PG8_LDB(B0, 0, 0); PG8_LDB(B1, 0, 1); PG8_SCHED; PG8_LDA(At, 0, 0); PG8_STAGE(PG8_SA(1, 1), a1 + hstep, voffA);
            PG8_WAIT_V(8); PG8_WAIT_L(0); PG8_BAR; PG8_MMA(0, 0, At, B0); PG8_MMA(0, 1, At, B1); PG8_BAR; PG8_SCHED;
            PG8_LDA(At, 0, 1); PG8_STAGE(PG8_SB(0, 0), b2, voffB); PG8_STAGE(PG8_SB(0, 1), b2 + hstep, voffB); PG8_STAGE(PG8_SA(0, 0), a2, voffA);
            PG8_WAIT_V(8); PG8_WAIT_L(0); PG8_BAR; PG8_MMA(1, 0, At, B0); PG8_MMA(1, 1, At, B1); PG8_BAR; PG8_SCHED;
            PG8_LDB(B0, 1, 0); PG8_LDB(B1, 1, 1); PG8_SCHED; PG8_LDA(At, 1, 0); PG8_STAGE(PG8_SA(0, 1), a2 + hstep, voffA);
            PG8_WAIT_V(8); PG8_WAIT_L(0); PG8_BAR; PG8_MMA(0, 0, At, B0); PG8_MMA(0, 1, At, B1); PG8_BAR; PG8_SCHED;
            PG8_LDA(At, 1, 1); PG8_STAGE(PG8_SB(1, 0), b3, voffB); PG8_STAGE(PG8_SB(1, 1), b3 + hstep, voffB); PG8_STAGE(PG8_SA(1, 0), a3, voffA);
            PG8_WAIT_V(8); PG8_WAIT_L(0); PG8_BAR; PG8_MMA(1, 0, At, B0); PG8_MMA(1, 1, At, B1); PG8_BAR; PG8_SCHED;
            } else {
            PG8_LDB(B0, 0, 0); PG8_SCHED; PG8_LDA(At, 0, 0); PG8_STAGE(PG8_SA(1, 1), a1 + hstep, voffA);
            PG8_WAIT_L(8); PG8_BAR; PG8_WAIT_L(0); PG8_MMA(0, 0, At, B0); PG8_BAR; PG8_SCHED;
            PG8_LDB(B1, 0, 1); PG8_STAGE(PG8_SB(0, 0), b2, voffB);
            PG8_BAR; PG8_WAIT_L(0); PG8_MMA(0, 1, At, B1); PG8_BAR;
            PG8_LDA(At, 0, 1); PG8_STAGE(PG8_SA(0, 0), a2, voffA);
            PG8_BAR; PG8_WAIT_L(0); PG8_MMA(1, 0, At, B0); PG8_BAR; PG8_SCHED;
            PG8_STAGE(PG8_SB(0, 1), b2 + hstep, voffB);
            PG8_WAIT_V(6); PG8_BAR; PG8_MMA(1, 1, At, B1); PG8_BAR;
            PG8_LDB(B0, 1, 0); PG8_SCHED; PG8_LDA(At, 1, 0); PG8_STAGE(PG8_SA(0, 1), a2 + hstep, voffA);
            PG8_WAIT_L(8); PG8_BAR; PG8_WAIT_L(0); PG8_MMA(0, 0, At, B0); PG8_BAR; PG8_SCHED;
            PG8_LDB(B1, 1, 1); PG8_STAGE(PG8_SB(1, 0), b3, voffB);
            PG8_BAR; PG8_WAIT_L(0); PG8_MMA(0, 1, At, B1); PG8_BAR;
            PG8_LDA(At, 1, 1); PG8_STAGE(PG8_SA(1, 0), a3, voffA);
            PG8_BAR; PG8_WAIT_L(0); PG8_MMA(1, 0, At, B0); PG8_BAR; PG8_SCHED;
            PG8_STAGE(PG8_SB(1, 1), b3 + hstep, voffB);
            PG8_WAIT_V(6); PG8_BAR; PG8_MMA(1, 1, At, B1); PG8_BAR;
            }
        }
        if constexpr (ALIGN_EPI) { if (wr == 0) PG8_BAR; }
        if constexpr (!Epi::AFTER_DRAIN) { E(acc, cur, wr, wc, fr, fq); S.done(cur); }
        if (!has_next) break;
#pragma unroll
        for (int a = 0; a < 2; ++a)
#pragma unroll
            for (int b = 0; b < 2; ++b)
#pragma unroll
                for (int m = 0; m < 4; ++m)
#pragma unroll
                    for (int n = 0; n < 2; ++n) acc[a][b][m][n] = (f32x4){0.f, 0.f, 0.f, 0.f};
        cur = nxt; cA = nA; cB = nB; ++ui;
        if constexpr (ALIGN_EPI) { if (wr == 1) PG8_BAR; }
    }
    PG8_WAIT_V(0);
    if constexpr (!ALIGN_EPI) { if (wr == 0) PG8_BAR; }
    PG8_BAR;
    if constexpr (Epi::AFTER_DRAIN) { E.fused(acc, cur, wr, wc, fr, fq, lds, wid, lane); S.done(cur); }
#undef PG8_SA
#undef PG8_SB
#undef PG8_STAGE
#undef PG8_LDA
#undef PG8_LDB
#undef PG8_MMA
#undef PG8_WAIT_V
#undef PG8_WAIT_L
#undef PG8_BAR
#undef PG8_SCHED
}
}
#define GAS __attribute__((address_space(1)))
#define LAS __attribute__((address_space(3)))
typedef unsigned short bf16;
typedef unsigned v4u __attribute__((ext_vector_type(4)));
typedef float f32x4 __attribute__((ext_vector_type(4)));
typedef short bf16x8 __attribute__((ext_vector_type(8)));
typedef GAS unsigned gu32;
typedef GAS unsigned long long gu64;
#define RLX_AGENT __ATOMIC_RELAXED, __HIP_MEMORY_SCOPE_AGENT
#define LDS_WAIT() asm volatile("s_waitcnt lgkmcnt(0)" ::: "memory")
#define VM_WAIT() asm volatile("s_waitcnt vmcnt(0)" ::: "memory")
__device__ __forceinline__ unsigned long long rt() { return __builtin_amdgcn_s_memrealtime(); }
__device__ __forceinline__ unsigned f2bf(float f) { unsigned u = __builtin_bit_cast(unsigned, f); return (u + 0x7fffu + ((u >> 16) & 1u)) >> 16; }
__device__ __forceinline__ unsigned pk2(float lo, float hi) { return f2bf(lo) | (f2bf(hi) << 16); }
#define XB_TMO      128
#define XB_XCNT(j)  (256  + 64 * (j))
#define XB_XSUB(j)  (1280 + 64 * (j))
#define XB_XGEN(j)  (2304 + 64 * (j))
#define XB_TOP      3328
#define XB_TOPGEN   3392
#define XCD_BAR_WORDS 3456
#define XB_SPIN_CAP (1u << 18)

__device__ __forceinline__ unsigned xb_ld(unsigned* p)              { return __hip_atomic_load(p, __ATOMIC_RELAXED, __HIP_MEMORY_SCOPE_AGENT); }
__device__ __forceinline__ unsigned xb_add(unsigned* p, unsigned v) { return __hip_atomic_fetch_add(p, v, __ATOMIC_RELAXED, __HIP_MEMORY_SCOPE_AGENT); }
__device__ __forceinline__ unsigned xb_xcc_id() { return (unsigned)__builtin_amdgcn_s_getreg((3 << 11) | 20) & 0xFu; }
#define XB_SPIN(cond, bar) do { unsigned _sp = 0; while (cond) { __builtin_amdgcn_s_sleep(1); \
    if ((++_sp & 255u) == 0u) { if (xb_ld(&(bar)[XB_TMO])) break; if (_sp > XB_SPIN_CAP) { atomicAdd(&(bar)[XB_TMO], 1u); break; } } } } while (0)

struct XcdBarrier {
    unsigned* bar; unsigned x;
    volatile LAS unsigned* st;
};

__device__ __forceinline__ XcdBarrier xcd_barrier_post(unsigned* bar, volatile LAS unsigned* st) {
    XcdBarrier b; b.bar = bar; b.x = xb_xcc_id(); b.st = st;
    if (threadIdx.x == 0) (void)xb_add(&bar[XB_XCNT(b.x)], 1u);
    return b;
}
__device__ __forceinline__ void xcd_barrier_complete(unsigned* bar, unsigned x, unsigned& nloc, unsigned& nx) {
    const unsigned G = gridDim.x * gridDim.y * gridDim.z;
    unsigned sum, cnt, mine, sp = 0u;
    for (;;) {
        sum = 0u; cnt = 0u; mine = 0u;
#pragma unroll
        for (unsigned j = 0; j < 16; ++j) { const unsigned c = xb_ld(&bar[XB_XCNT(j)]); sum += c; cnt += (c > 0u) ? 1u : 0u; mine = (j == x) ? c : mine; }
        if (sum == G) break;
        __builtin_amdgcn_s_sleep(1);
        if ((++sp & 255u) == 0u) { if (xb_ld(&bar[XB_TMO])) break; if (sp > XB_SPIN_CAP) { atomicAdd(&bar[XB_TMO], 1u); break; } }
    }
    nloc = mine > 0u ? mine : 1u; nx = cnt > 0u ? cnt : 1u;
}

__device__ __forceinline__ void xcd_barrier(const XcdBarrier& b) {
    asm volatile("s_waitcnt vmcnt(0)" ::: "memory");
    __syncthreads();
    if (threadIdx.x == 0) {
        unsigned* bar = b.bar;
        __builtin_amdgcn_s_waitcnt(0);
        unsigned nloc = b.st[0], nx = b.st[1];
        if (nloc == 0u) { xcd_barrier_complete(bar, b.x, nloc, nx); b.st[0] = nloc; b.st[1] = nx; }
        const unsigned old = xb_add(&bar[XB_XSUB(b.x)], 1u);
        const unsigned gen = old / nloc;
        if (old + 1u == (gen + 1u) * nloc) {
            __builtin_amdgcn_fence(__ATOMIC_RELEASE, "agent");
            asm volatile("s_waitcnt vmcnt(0)" ::: "memory");
            const unsigned og = xb_add(&bar[XB_TOP], 1u);
            const unsigned tg = og / nx;
            if (og + 1u == (tg + 1u) * nx) xb_add(&bar[XB_TOPGEN], 1u);
            else XB_SPIN(xb_ld(&bar[XB_TOPGEN]) == tg, bar);
            __builtin_amdgcn_fence(__ATOMIC_ACQUIRE, "agent");
            xb_add(&bar[XB_XGEN(b.x)], 1u);
            asm volatile("s_waitcnt vmcnt(0)" ::: "memory");
        } else {
            XB_SPIN(xb_ld(&bar[XB_XGEN(b.x)]) == gen, bar);
            __builtin_amdgcn_fence(__ATOMIC_ACQUIRE, "agent");
            asm volatile("s_waitcnt vmcnt(0)" ::: "memory");
        }
    }
    __syncthreads();
}
constexpr int NWAVES = 8, NTHR = 512;
constexpr int D = 1024, SEQ = 8192, CTXL = 256, MLAT = 16384, MCTX = 512, MTOT = MLAT + MCTX, FF = 4096, NH = 16, HD = 64, KMIX = 1536;
constexpr float EPS = 1e-6f;
constexpr float QSCALE = 0.125f * 1.4426950408889634f;
constexpr float LOG2E = 1.4426950408889634f;
constexpr size_t MiB = 1u << 20;
constexpr size_t WS_CTL = 0, CTL_ZERO_BYTES = 1 * MiB;
constexpr size_t WS_MOD = 1 * MiB;
constexpr size_t WS_GAINS = 1 * MiB + 192 * 1024;
constexpr size_t WS_TRIG = 1 * MiB + 256 * 1024;
constexpr size_t WS_WIN = 4 * MiB, WS_WOUT0 = 8 * MiB, WS_W1_0 = 12 * MiB, WS_W2_0 = 20 * MiB, WS_WQKV = 28 * MiB, WS_WOUT1 = 34 * MiB, WS_W1_1 = 36 * MiB, WS_W2_1 = 44 * MiB;
constexpr size_t WS_XN = 52 * MiB;
constexpr size_t WS_CTXS = 86 * MiB;
constexpr size_t WS_PB = 88 * MiB, WS_AB = 105 * MiB, WS_FB = 122 * MiB, WS_ARE = 139 * MiB, WS_AIM = 155 * MiB, WS_MIXIN = 171 * MiB;
constexpr size_t WS_HB = 88 * MiB;
constexpr size_t WS_QB = 88 * MiB, WS_KB = 121 * MiB, WS_VB = 154 * MiB, WS_OB = 187 * MiB;
constexpr size_t WS_END = 256 * MiB;
static_assert(WS_MIXIN + (size_t)MTOT * KMIX * 2 <= WS_END && WS_HB + (size_t)MTOT * FF * 2 <= WS_END && WS_OB + (size_t)MLAT * D * 2 <= WS_END, "ws map");
constexpr int CW_BAR = 4096;
constexpr int RING_OFF = 0, RING_BYTES = 131072;
constexpr int LDSCTL_OFF = RING_BYTES, MISC_OFF = LDSCTL_OFF + 320;
constexpr int LDS_BYTES = 147456;

struct Ctx {
    LAS unsigned char* lds; int tid, lane, wave, gw, ngw, gt, ngt, G;
};

__device__ __forceinline__ float wave_sum(float v) {
#pragma unroll
    for (int o = 1; o < 64; o <<= 1) v += __shfl_xor(v, o);
    return v;
}
__device__ __forceinline__ float wave_max(float v) {
#pragma unroll
    for (int o = 1; o < 64; o <<= 1) v = fmaxf(v, __shfl_xor(v, o));
    return v;
}
__device__ __forceinline__ float bf2f(unsigned short h) { return __builtin_bit_cast(float, (unsigned)h << 16); }
__device__ __forceinline__ void unpack8(const v4u w, float (&f)[8]) {
    f[0] = __builtin_bit_cast(float, w.x << 16); f[1] = __builtin_bit_cast(float, w.x & 0xffff0000u);
    f[2] = __builtin_bit_cast(float, w.y << 16); f[3] = __builtin_bit_cast(float, w.y & 0xffff0000u);
    f[4] = __builtin_bit_cast(float, w.z << 16); f[5] = __builtin_bit_cast(float, w.z & 0xffff0000u);
    f[6] = __builtin_bit_cast(float, w.w << 16); f[7] = __builtin_bit_cast(float, w.w & 0xffff0000u);
}
__device__ __forceinline__ v4u pack8(const float (&f)[8]) { v4u o; o.x = pk2(f[0], f[1]); o.y = pk2(f[2], f[3]); o.z = pk2(f[4], f[5]); o.w = pk2(f[6], f[7]); return o; }

__device__ __forceinline__ int rowmap(int code, int n) {
    if (code == 1) {
        const int part = n >> 9, ch = n & 511, pn = ch >> 6, w = ch & 63, wc = w >> 4, fq = (w >> 2) & 3, e = w & 3, bj = part >> 1, nn = part & 1;
        return 256 * pn + 128 * bj + 32 * wc + 16 * nn + 4 * fq + e;
    }
    if (code == 2) {
        const int pn = n >> 8, w = n & 255, wc = w >> 6, bj = (w >> 5) & 1, x = w & 31;
        return 256 * pn + 128 * bj + 32 * wc + x;
    }
    return n;
}
__device__ __forceinline__ void transpose_item(const float* W, int N, bf16* WT, int KP, int koff, int code, LAS float* scr, int item, int lane) {
    const int nblk = N / 32, kb = item / nblk, nb = item % nblk, k0 = 64 * kb, n0 = 32 * nb;
#pragma unroll 8
    for (int i = 0; i < 32; ++i) { const int kk = 2 * i + (lane >> 5); scr[kk * 33 + (lane & 31)] = W[(size_t)(k0 + kk) * N + n0 + (lane & 31)]; }
    LDS_WAIT(); asm volatile("" ::: "memory");
    const int c = lane & 7;
#pragma unroll
    for (int j = 0; j < 4; ++j) { const int n = (lane >> 3) + 8 * j; const LAS float* s = scr + (8 * c) * 33 + n;
        v4u o; o.x = pk2(s[0 * 33], s[1 * 33]); o.y = pk2(s[2 * 33], s[3 * 33]); o.z = pk2(s[4 * 33], s[5 * 33]); o.w = pk2(s[6 * 33], s[7 * 33]);
        *(GAS v4u*)(WT + (size_t)rowmap(code, n0 + n) * KP + koff + k0 + 8 * c) = o; }
    LDS_WAIT(); asm volatile("" ::: "memory");
}
__device__ __forceinline__ void fold_item(const float* Wout, bf16* WT, LAS float* scr, const LAS float* tab, int item, int lane) {
    const int g = item >> 5, nb = item & 31, k0 = 512 + 64 * g, n0 = 32 * nb;
#pragma unroll 8
    for (int i = 0; i < 32; ++i) { const int kk = 2 * i + (lane >> 5); scr[kk * 33 + (lane & 31)] = Wout[(size_t)(k0 + kk) * 1024 + n0 + (lane & 31)]; }
    LDS_WAIT(); asm volatile("" ::: "memory");
    const int c8 = lane & 7;
    for (int j = 0; j < 4; ++j) { const int n = (lane >> 3) + 8 * j;
        float aP[8], aQ[8];
#pragma unroll
        for (int i = 0; i < 8; ++i) { aP[i] = 0.f; aQ[i] = 0.f; }
        for (int m = 0; m < 64; ++m) { const float x = scr[m * 33 + n];
#pragma unroll
            for (int i = 0; i < 8; ++i) { const int idx = ((8 * c8 + i) * m) & 63; aP[i] += tab[idx] * x; aQ[i] -= tab[64 + idx] * x; } }
        *(GAS v4u*)(WT + (size_t)(n0 + n) * KMIX + 512 + 64 * g + 8 * c8) = pack8(aP);
        *(GAS v4u*)(WT + (size_t)(n0 + n) * KMIX + 1024 + 64 * g + 8 * c8) = pack8(aQ); }
    LDS_WAIT(); asm volatile("" ::: "memory");
}

struct In { const float *x, *c, *ctx, *c_ctx, *ada_w, *ada_b, *nmix_g, *nmlp_g, *w1, *w2, *w_in, *conv_w, *w_out0, *w_qkv, *q_g, *k_g, *rpb, *w_out1; };

__device__ __forceinline__ void p0_prologue(const Ctx& F, const In& I, unsigned char* ws) {
    { float* trig = (float*)(ws + WS_TRIG); for (int j = F.gt; j < 8192; j += F.ngt) { trig[2 * j] = cospif((float)j * (1.0f / 4096.0f)); trig[2 * j + 1] = sinpif((float)j * (1.0f / 4096.0f)); } }
    if (F.gt < 128) ((float*)(ws + WS_GAINS))[F.gt] = F.gt < 64 ? I.q_g[F.gt] * QSCALE : I.k_g[F.gt - 64];
    if (blockIdx.x < 192) {
        LAS float* sc = (LAS float*)(F.lds);
        LAS float* red = (LAS float*)(F.lds + 12288);
        for (int i = F.tid; i < 3 * 1024; i += NTHR) { const int g = i >> 10, k = i & 1023; const float xv = g < 2 ? I.c[g * 1024 + k] : I.c_ctx[k]; sc[i] = xv / (1.0f + __expf(-xv)); }
        __syncthreads();
        const int layer = blockIdx.x / 96, cg = blockIdx.x % 96, col = cg * 64 + F.lane;
        const float* W = I.ada_w + (size_t)layer * 1024 * 6144 + col;
        float a0 = 0.f, a1 = 0.f, a2 = 0.f;
#pragma unroll 16
        for (int kk = 0; kk < 128; ++kk) { const int k = F.wave * 128 + kk; const float wv = W[(size_t)k * 6144]; a0 += sc[k] * wv; a1 += sc[1024 + k] * wv; a2 += sc[2048 + k] * wv; }
        red[(F.wave * 3 + 0) * 64 + F.lane] = a0; red[(F.wave * 3 + 1) * 64 + F.lane] = a1; red[(F.wave * 3 + 2) * 64 + F.lane] = a2;
        __syncthreads();
        if (F.wave < 3) { float s = I.ada_b[layer * 6144 + col];
#pragma unroll
            for (int w = 0; w < 8; ++w) s += red[(w * 3 + F.wave) * 64 + F.lane];
            ((float*)(ws + WS_MOD))[(layer * 3 + F.wave) * 6144 + col] = s; }
        __syncthreads();
    }
    LAS float* scr = (LAS float*)(F.lds + RING_OFF + F.wave * 16384);
    LAS float* tab = scr + 2112;
    tab[F.lane] = cospif((float)F.lane * (1.0f / 32.0f)); tab[64 + F.lane] = sinpif((float)F.lane * (1.0f / 32.0f));
    LDS_WAIT(); asm volatile("" ::: "memory");
    constexpr int I_WIN = 16 * 64, I_WO0 = 8 * 32, I_FOLD = 8 * 32, I_W1 = 16 * 128, I_W2 = 64 * 32, I_QKV = 16 * 96, I_WO1 = 16 * 32;
    constexpr int NITEMS = I_WIN + I_WO0 + I_FOLD + 2 * I_W1 + 2 * I_W2 + I_QKV + I_WO1;
    for (int it = F.gw; it < NITEMS; it += F.ngw) {
        int r = it;
        if (r < I_WIN) { transpose_item(I.w_in, 2048, (bf16*)(ws + WS_WIN), 1024, 0, 1, scr, r, F.lane); continue; } r -= I_WIN;
        if (r < I_WO0) { transpose_item(I.w_out0, 1024, (bf16*)(ws + WS_WOUT0), KMIX, 0, 0, scr, r, F.lane); continue; } r -= I_WO0;
        if (r < I_FOLD) { fold_item(I.w_out0, (bf16*)(ws + WS_WOUT0), scr, tab, r, F.lane); continue; } r -= I_FOLD;
        if (r < I_W1) { transpose_item(I.w1, 4096, (bf16*)(ws + WS_W1_0), 1024, 0, 0, scr, r, F.lane); continue; } r -= I_W1;
        if (r < I_W1) { transpose_item(I.w1 + (size_t)1024 * 4096, 4096, (bf16*)(ws + WS_W1_1), 1024, 0, 0, scr, r, F.lane); continue; } r -= I_W1;
        if (r < I_W2) { transpose_item(I.w2, 1024, (bf16*)(ws + WS_W2_0), 4096, 0, 0, scr, r, F.lane); continue; } r -= I_W2;
        if (r < I_W2) { transpose_item(I.w2 + (size_t)4096 * 1024, 1024, (bf16*)(ws + WS_W2_1), 4096, 0, 0, scr, r, F.lane); continue; } r -= I_W2;
        if (r < I_QKV) { transpose_item(I.w_qkv, 3072, (bf16*)(ws + WS_WQKV), 1024, 0, 2, scr, r, F.lane); continue; } r -= I_QKV;
        transpose_item(I.w_out1, 1024, (bf16*)(ws + WS_WOUT1), 1024, 0, 0, scr, r, F.lane);
    }
}

__device__ __forceinline__ void norm_phase(const Ctx& F, const float* lat, const float* ctx, int nrows, const float* gain, const float* mod, bf16* XN) {
    for (int m = F.gw; m < nrows; m += F.ngw) {
        const float* xrow = m < MLAT ? lat + (size_t)m * D : ctx + (size_t)(m - MLAT) * D;
        const int grp = m < SEQ ? 0 : (m < MLAT ? 1 : 2);
        const float* mg = mod + grp * 6144;
        const GAS f32x4* xr = (const GAS f32x4*)xrow + F.lane;
        f32x4 v[4]; float s = 0.f;
#pragma unroll
        for (int j = 0; j < 4; ++j) { v[j] = xr[64 * j]; s += (v[j].x * v[j].x + v[j].y * v[j].y) + (v[j].z * v[j].z + v[j].w * v[j].w); }
        const float rstd = rsqrtf(wave_sum(s) * (1.f / D) + EPS);
        GAS unsigned long long* o8 = (GAS unsigned long long*)(XN + (size_t)m * D) + F.lane;
#pragma unroll
        for (int j = 0; j < 4; ++j) { const int col = 4 * F.lane + 256 * j;
            const f32x4 gg = *(const f32x4*)(gain + col), sh = *(const f32x4*)(mg + col), sc = *(const f32x4*)(mg + 1024 + col);
            const f32x4 y = (v[j] * rstd) * gg * (sc + 1.0f) + sh;
            o8[64 * j] = (unsigned long long)pk2(y.x, y.y) | ((unsigned long long)pk2(y.z, y.w) << 32); }
    }
}

__device__ __forceinline__ void conv_phase(const Ctx& F, const bf16* PB, const bf16* AB, const float* cw, bf16* MIX) {
    for (int it = F.gt; it < MTOT * 64; it += F.ngt) {
        const int row = it >> 6, ch = (it & 63) * 8;
        int t, L; if (row < MLAT) { t = row & (SEQ - 1); L = SEQ; } else { t = (row - MLAT) & (CTXL - 1); L = CTXL; }
        float pc[8], pp[8], pn[8], ab[8], o[8];
        unpack8(*(const GAS v4u*)(PB + (size_t)row * 512 + ch), pc);
        unpack8(*(const GAS v4u*)(AB + (size_t)row * 512 + ch), ab);
        if (t > 0) unpack8(*(const GAS v4u*)(PB + (size_t)(row - 1) * 512 + ch), pp); else { for (int i = 0; i < 8; ++i) pp[i] = 0.f; }
        if (t < L - 1) unpack8(*(const GAS v4u*)(PB + (size_t)(row + 1) * 512 + ch), pn); else { for (int i = 0; i < 8; ++i) pn[i] = 0.f; }
#pragma unroll
        for (int i = 0; i < 8; ++i) o[i] = ab[i] * (cw[ch + i] * pp[i] + cw[512 + ch + i] * pc[i] + cw[1024 + ch + i] * pn[i]);
        *(GAS v4u*)(MIX + (size_t)row * KMIX + ch) = pack8(o);
    }
}
__device__ __forceinline__ void fft1_simple(const Ctx& F, const bf16* FB, const float* trig, bf16* ARE, bf16* AIM) {
    for (int it = F.gt; it < (1 << 20); it += F.ngt) {
        const int ch = (it & 63) * 8, t2 = (it >> 6) & 63, k1 = (it >> 12) & 127, b = it >> 19;
        float ar[8], ai[8];
#pragma unroll
        for (int i = 0; i < 8; ++i) { ar[i] = 0.f; ai[i] = 0.f; }
        for (int t1 = 0; t1 < 128; ++t1) {
            float x[8]; unpack8(*(const GAS v4u*)(FB + (size_t)(b * SEQ + 64 * t1 + t2) * 512 + ch), x);
            const int idx = (64 * k1 * t1) & 8191; const float c = trig[2 * idx], s = trig[2 * idx + 1];
#pragma unroll
            for (int i = 0; i < 8; ++i) { ar[i] += c * x[i]; ai[i] += s * x[i]; }
        }
        const int idx = (k1 * t2) & 8191; const float c = trig[2 * idx], s = trig[2 * idx + 1];
        float br[8], bi[8];
#pragma unroll
        for (int i = 0; i < 8; ++i) { br[i] = ar[i] * c - ai[i] * s; bi[i] = ar[i] * s + ai[i] * c; }
        const size_t off = ((size_t)(b * 128 + k1) * 64 + t2) * 512 + ch;
        *(GAS v4u*)(ARE + off) = pack8(br); *(GAS v4u*)(AIM + off) = pack8(bi);
    }
}
__device__ __forceinline__ void fftc_simple(const Ctx& F, const bf16* FB, const float* trig, bf16* MIX) {
    for (int it = F.gt; it < 2 * 256 * 64; it += F.ngt) {
        const int ch = (it & 63) * 8, k = (it >> 6) & 255, b = it >> 14;
        float p[8], q[8];
#pragma unroll
        for (int i = 0; i < 8; ++i) { p[i] = 0.f; q[i] = 0.f; }
        for (int t = 0; t < 256; ++t) {
            float x[8]; unpack8(*(const GAS v4u*)(FB + (size_t)(MLAT + b * 256 + t) * 512 + ch), x);
            const int idx = (32 * k * t) & 8191; const float c = trig[2 * idx], s = trig[2 * idx + 1];
#pragma unroll
            for (int i = 0; i < 8; ++i) { p[i] += c * x[i]; q[i] += s * x[i]; }
        }
#pragma unroll
        for (int i = 0; i < 8; ++i) { p[i] *= (1.0f / 128.0f); q[i] *= (1.0f / 128.0f); }
        const size_t off = (size_t)(MLAT + b * 256 + k) * KMIX + ch;
        *(GAS v4u*)(MIX + off + 512) = pack8(p); *(GAS v4u*)(MIX + off + 1024) = pack8(q);
    }
}
__device__ __forceinline__ void fft2_simple(const Ctx& F, const bf16* ARE, const bf16* AIM, const float* trig, bf16* MIX) {
    for (int it = F.gt; it < (1 << 20); it += F.ngt) {
        const int ch = (it & 63) * 8, k1 = (it >> 6) & 127, k2 = (it >> 13) & 63, b = it >> 19;
        float p[8], q[8];
#pragma unroll
        for (int i = 0; i < 8; ++i) { p[i] = 0.f; q[i] = 0.f; }
        for (int t2 = 0; t2 < 64; ++t2) {
            const size_t off = ((size_t)(b * 128 + k1) * 64 + t2) * 512 + ch;
            float br[8], bi[8]; unpack8(*(const GAS v4u*)(ARE + off), br); unpack8(*(const GAS v4u*)(AIM + off), bi);
            const int idx = (128 * k2 * t2) & 8191; const float c = trig[2 * idx], s = trig[2 * idx + 1];
#pragma unroll
            for (int i = 0; i < 8; ++i) { p[i] += c * br[i] - s * bi[i]; q[i] += s * br[i] + c * bi[i]; }
        }
        const float sc = 0.0013810679320049757f;
#pragma unroll
        for (int i = 0; i < 8; ++i) { p[i] *= sc; q[i] *= sc; }
        const size_t off = (size_t)(b * SEQ + k1 + 128 * k2) * KMIX + ch;
        *(GAS v4u*)(MIX + off + 512) = pack8(p); *(GAS v4u*)(MIX + off + 1024) = pack8(q);
    }
}
__device__ __forceinline__ void na_simple(const Ctx& F, const bf16* QB, const bf16* KB, const bf16* VB, const float* rpb, bf16* OB) {
    LAS float* pbuf = (LAS float*)(F.lds + F.wave * 16384);
    for (int task = F.gw; task < MLAT * NH; task += F.ngw) {
        const int h = task & 15, row = task >> 4, b = row >> 13, t = row & 8191, r = t >> 6, c = t & 63;
        const int rs = min(max(r - 4, 0), 120), cs = min(max(c - 8, 0), 48);
        float q[64];
#pragma unroll
        for (int i = 0; i < 8; ++i) { float tmp[8]; unpack8(*(const GAS v4u*)(QB + (size_t)row * D + h * 64 + 8 * i), tmp);
#pragma unroll
            for (int e = 0; e < 8; ++e) q[8 * i + e] = tmp[e]; }
        float sv[6]; float mx = -3.0e38f;
#pragma unroll
        for (int i = 0; i < 6; ++i) { const int j = F.lane + 64 * i; size_t krow; float bias = 0.f;
            if (j < 128) { const int rr = rs + (j >> 4), cc = cs + (j & 15); krow = (size_t)b * SEQ + rr * 64 + cc; bias = rpb[(h * 15 + (rr - r + 7)) * 31 + (cc - c + 15)] * LOG2E; }
            else krow = (size_t)MLAT + b * 256 + (j - 128);
            float dot = 0.f;
#pragma unroll
            for (int i8 = 0; i8 < 8; ++i8) { float kk[8]; unpack8(*(const GAS v4u*)(KB + krow * D + h * 64 + 8 * i8), kk);
#pragma unroll
                for (int e = 0; e < 8; ++e) dot += q[8 * i8 + e] * kk[e]; }
            sv[i] = dot + bias; mx = fmaxf(mx, sv[i]); }
        mx = wave_max(mx);
        float l = 0.f;
#pragma unroll
        for (int i = 0; i < 6; ++i) { const float p = exp2f(sv[i] - mx); l += p; pbuf[F.lane + 64 * i] = p; }
        l = wave_sum(l);
        LDS_WAIT(); asm volatile("" ::: "memory");
        float o = 0.f;
        for (int j = 0; j < 384; ++j) { size_t krow;
            if (j < 128) krow = (size_t)b * SEQ + (rs + (j >> 4)) * 64 + cs + (j & 15); else krow = (size_t)MLAT + b * 256 + (j - 128);
            o += pbuf[j] * bf2f(VB[krow * D + h * 64 + F.lane]); }
        OB[(size_t)row * D + h * 64 + F.lane] = (bf16)f2bf(o / l);
        LDS_WAIT(); asm volatile("" ::: "memory");
    }
}
#ifndef MK_MULTI
#define MK_MULTI 0
#endif
constexpr int NPHASE = 16;
struct Args { const float* in[18]; float* out; unsigned char* ws; int ph_lo, ph_hi; };
__global__ void __launch_bounds__(NTHR, 2) hyb_fwd(Args args) {
    extern __shared__ __attribute__((aligned(16))) unsigned char lds_raw[];
    Ctx F; F.lds = (LAS unsigned char*)lds_raw; F.tid = threadIdx.x; F.lane = F.tid & 63; F.wave = __builtin_amdgcn_readfirstlane(F.tid >> 6); F.G = gridDim.x;
    { const int bx = blockIdx.x; const int vcu = (F.G % 8 == 0) ? (bx % 8) * (F.G / 8) + bx / 8 : bx;
      F.gw = vcu * NWAVES + F.wave; F.ngw = F.G * NWAVES; F.gt = vcu * NTHR + F.tid; F.ngt = F.G * NTHR; }
    unsigned char* ws = args.ws;
    In I; I.x = args.in[0]; I.c = args.in[1]; I.ctx = args.in[2]; I.c_ctx = args.in[3]; I.ada_w = args.in[4]; I.ada_b = args.in[5]; I.nmix_g = args.in[6]; I.nmlp_g = args.in[7];
    I.w1 = args.in[8]; I.w2 = args.in[9]; I.w_in = args.in[10]; I.conv_w = args.in[11]; I.w_out0 = args.in[12]; I.w_qkv = args.in[13]; I.q_g = args.in[14]; I.k_g = args.in[15]; I.rpb = args.in[16]; I.w_out1 = args.in[17];
    float* out = args.out;
    for (int u = F.tid; u < (LDS_BYTES - LDSCTL_OFF) / 4; u += NTHR) ((LAS unsigned*)(F.lds + LDSCTL_OFF))[u] = 0u;
    __syncthreads();
    XcdBarrier bar; bar.bar = (unsigned*)(ws + WS_CTL) + CW_BAR; bar.x = 0; bar.st = nullptr;
    if (!MK_MULTI) bar = xcd_barrier_post((unsigned*)(ws + WS_CTL) + CW_BAR, (volatile LAS unsigned*)(F.lds + MISC_OFF) + 8);
    const int lo = args.ph_lo, hi = args.ph_hi;
#define IN(k) (lo <= (k) && (k) < hi)
#define SEAM(k) do { if (IN(k) && IN((k) + 1)) xcd_barrier(bar); } while (0)
    const float* MOD = (const float*)(ws + WS_MOD);
    const float* trig = (const float*)(ws + WS_TRIG);
    bf16* XN = (bf16*)(ws + WS_XN); float* CTXS = (float*)(ws + WS_CTXS);
    bf16 *PB = (bf16*)(ws + WS_PB), *AB = (bf16*)(ws + WS_AB), *FB = (bf16*)(ws + WS_FB), *ARE = (bf16*)(ws + WS_ARE), *AIM = (bf16*)(ws + WS_AIM), *MIX = (bf16*)(ws + WS_MIXIN);
    bf16 *HB = (bf16*)(ws + WS_HB), *QB = (bf16*)(ws + WS_QB), *KB = (bf16*)(ws + WS_KB), *VB = (bf16*)(ws + WS_VB), *OB = (bf16*)(ws + WS_OB);
    LAS unsigned char* ring = F.lds + RING_OFF;
    const int bid = (int)blockIdx.x;

    if (IN(0)) { p0_prologue(F, I, ws); } SEAM(0);
    if (IN(1)) { norm_phase(F, I.x, I.ctx, MTOT, I.nmix_g, MOD, XN); } SEAM(1);
    if (IN(2)) { pg8::Gemm g{XN, (const bf16*)(ws + WS_WIN), MTOT, 2048, 1024}; pg8::StaticOrder S; S.init(MTOT, 2048, F.G, bid);
        pg8::EpiWin E{PB, AB, FB}; pg8::gemm_phase<pg8::EpiWin, pg8::StaticOrder, true, true>(ring, g, S, E); } SEAM(2);
    if (IN(3)) { conv_phase(F, PB, AB, I.conv_w, MIX); fft1_simple(F, FB, trig, ARE, AIM); fftc_simple(F, FB, trig, MIX); } SEAM(3);
    if (IN(4)) { fft2_simple(F, ARE, AIM, trig, MIX); } SEAM(4);
    if (IN(5)) { pg8::Gemm g{MIX, (const bf16*)(ws + WS_WOUT0), MTOT, 1024, KMIX}; pg8::StaticOrder S; S.init(MTOT, 1024, F.G, bid);
        pg8::EpiRes E{I.x, I.ctx, out, CTXS, MOD + 2048}; pg8::gemm_phase<pg8::EpiRes, pg8::StaticOrder, true, true>(ring, g, S, E); } SEAM(5);
    if (IN(6)) { norm_phase(F, out, CTXS, MTOT, I.nmlp_g, MOD + 3072, XN); } SEAM(6);
    if (IN(7)) { pg8::Gemm g{XN, (const bf16*)(ws + WS_W1_0), MTOT, FF, 1024}; pg8::StaticOrder S; S.init(MTOT, FF, F.G, bid);
        pg8::EpiRelu2 E{HB, FF}; pg8::gemm_phase<pg8::EpiRelu2, pg8::StaticOrder, true, true>(ring, g, S, E); } SEAM(7);
    if (IN(8)) { pg8::Gemm g{HB, (const bf16*)(ws + WS_W2_0), MTOT, 1024, FF}; pg8::StaticOrder S; S.init(MTOT, 1024, F.G, bid);
        pg8::EpiRes E{out, CTXS, out, CTXS, MOD + 5120}; pg8::gemm_phase<pg8::EpiRes, pg8::StaticOrder, true, true>(ring, g, S, E); } SEAM(8);
    if (IN(9)) { norm_phase(F, out, CTXS, MTOT, I.nmix_g + 1024, MOD + 18432, XN); } SEAM(9);
    if (IN(10)) { pg8::Gemm g{XN, (const bf16*)(ws + WS_WQKV), MTOT, 3072, 1024}; pg8::StaticOrder S; S.init(MTOT, 3072, F.G, bid);
        pg8::EpiQkv E{QB, (size_t)(WS_KB - WS_QB) / 2, (const float*)(ws + WS_GAINS)}; pg8::gemm_phase<pg8::EpiQkv, pg8::StaticOrder, true, true>(ring, g, S, E); } SEAM(10);
    if (IN(11)) { na_simple(F, QB, KB, VB, I.rpb, OB); } SEAM(11);
    if (IN(12)) { pg8::Gemm g{OB, (const bf16*)(ws + WS_WOUT1), MLAT, 1024, 1024}; pg8::StaticOrder S; S.init(MLAT, 1024, F.G, bid);
        pg8::EpiRes E{out, CTXS, out, CTXS, MOD + 18432 + 2048}; pg8::gemm_phase<pg8::EpiRes, pg8::StaticOrder, true, true>(ring, g, S, E); } SEAM(12);
    if (IN(13)) { norm_phase(F, out, CTXS, MLAT, I.nmlp_g + 1024, MOD + 18432 + 3072, XN); } SEAM(13);
    if (IN(14)) { pg8::Gemm g{XN, (const bf16*)(ws + WS_W1_1), MLAT, FF, 1024}; pg8::StaticOrder S; S.init(MLAT, FF, F.G, bid);
        pg8::EpiRelu2 E{HB, FF}; pg8::gemm_phase<pg8::EpiRelu2, pg8::StaticOrder, true, true>(ring, g, S, E); } SEAM(14);
    if (IN(15)) { pg8::Gemm g{HB, (const bf16*)(ws + WS_W2_1), MLAT, 1024, FF}; pg8::StaticOrder S; S.init(MLAT, 1024, F.G, bid);
        pg8::EpiRes E{out, CTXS, out, CTXS, MOD + 18432 + 5120}; pg8::gemm_phase<pg8::EpiRes, pg8::StaticOrder, true, true>(ring, g, S, E); }
#undef IN
#undef SEAM
}

extern "C" void kernel_launch(void* const* d_in, const int* in_sizes, int n_in, void* d_out, int out_size, void* d_ws, size_t ws_size, hipStream_t stream) {
    static int grid = 0;
    if (grid == 0) {
        if (n_in != 18 || out_size != MLAT * D || ws_size < WS_END) { fprintf(stderr, "kernel_launch: unexpected shapes (n_in %d out %d ws %zu)\n", n_in, out_size, ws_size); grid = -1; return; }
        int dev = 0, cus = 0;
        if (hipGetDevice(&dev) != hipSuccess || hipDeviceGetAttribute(&cus, hipDeviceAttributeMultiprocessorCount, dev) != hipSuccess) { grid = -1; return; }
        if (hipFuncSetAttribute((const void*)hyb_fwd, hipFuncAttributeMaxDynamicSharedMemorySize, LDS_BYTES) != hipSuccess) { fprintf(stderr, "kernel_launch: hipFuncSetAttribute failed\n"); grid = -1; return; }
        (void)hipGetLastError();
        grid = cus;
    }
    if (grid < 0) return;
    if (hipMemsetAsync((char*)d_ws + WS_CTL, 0, CTL_ZERO_BYTES, stream) != hipSuccess) return;
    Args a{};
    for (int i = 0; i < 18; ++i) a.in[i] = (const float*)d_in[i];
    a.out = (float*)d_out; a.ws = (unsigned char*)d_ws;
#if MK_MULTI
    for (int p = 0; p < NPHASE; ++p) { a.ph_lo = p; a.ph_hi = p + 1; hipLaunchKernelGGL(hyb_fwd, dim3(grid), dim3(NTHR), LDS_BYTES, stream, a); }
#else
    a.ph_lo = 0; a.ph_hi = NPHASE; hipLaunchKernelGGL(hyb_fwd, dim3(grid), dim3(NTHR), LDS_BYTES, stream, a);
#endif
}
```

```cpp
#define DFT_X3 1
#define S1NT 2
#include <hip/hip_runtime.h>
#include <cstdio>
#include <cstdint>
namespace pg8 {
#define PG8_LAS __attribute__((address_space(3)))
typedef unsigned short bf16_t;
typedef short bf16x8 __attribute__((ext_vector_type(8)));
typedef float f32x4 __attribute__((ext_vector_type(4)));
typedef unsigned u32x4 __attribute__((ext_vector_type(4)));
constexpr int BM = 256, BK = 64, HALF = 128, HTB = HALF * BK * 2  , STAGE_BYTES = 8 * HTB, NXCD = 8, WGM = 8;

__host__ __device__ __forceinline__ int lds_byte(int r, int c) { const int st = (r >> 4) * 2 + (c >> 5), rr = r & 15, cc = c & 31, ob = rr * 64 + cc * 2; return st * 1024 + (ob ^ (((ob >> 9) & 1) << 5)); }
__host__ __device__ __forceinline__ void stage_rc(int b, int& R, int& C) { const int st = b / 1024, sb = b % 1024, swz = sb ^ (((sb >> 9) & 1) << 5); R = (st >> 1) * 16 + swz / 64; C = (st & 1) * 32 + (swz % 64) / 2; }
__host__ __device__ __forceinline__ int perm32(int rho) { const int n = rho >> 4, i = rho & 15; return 8 * (i >> 2) + 4 * n + (i & 3); }

struct Unit { int pm, pn; };
struct Gemm { const bf16_t* A; const bf16_t* Bt; int M, N, K; };

struct StaticOrder {
    int nM, nN, nwg, G, c;
    __host__ __device__ void init(int M, int N, int G_, int c_) { nM = M / BM; nN = N / BM; nwg = nM * nN; G = G_; c = c_; }
    __host__ __device__ bool next(int i, Unit& u) const {
        const long L = (long)i * G + c; if (L >= nwg) return false;
        int wgid = (int)L; { const int q = nwg / NXCD, r = nwg % NXCD, xcd = wgid % NXCD, off = wgid / NXCD; wgid = (xcd < r ? xcd * (q + 1) : r * (q + 1) + (xcd - r) * q) + off; }
        const int nig = WGM * nN, gid = wgid / nig, fm = gid * WGM, gsz = (nM - fm) < WGM ? (nM - fm) : WGM;
        u.pm = fm + ((wgid % nig) % gsz); u.pn = (wgid % nig) / gsz; return true;
    }
    __device__ __forceinline__ void a_ready(const Unit&) const {}
    __device__ __forceinline__ void done(const Unit&) const {}
};

__device__ __forceinline__ unsigned cvt_pk_bf16(float lo, float hi) { unsigned r; asm volatile("v_cvt_pk_bf16_f32 %0, %1, %2" : "=v"(r) : "v"(lo), "v"(hi)); return r; }
typedef float f32x2 __attribute__((ext_vector_type(2)));
typedef unsigned u32x2 __attribute__((ext_vector_type(2)));
struct EpiWin {
    static constexpr bool PERM = false, AFTER_DRAIN = false;
    bf16_t *PB, *AB, *FB;
    __device__ __forceinline__ void operator()(const f32x4 (&acc)[2][2][4][2], const Unit& u, int wr, int wc, int fr, int fq) const {
        const int ch0 = u.pn * 64 + wc * 16 + fq * 4;
#pragma unroll
        for (int ai = 0; ai < 2; ++ai)
#pragma unroll
            for (int m = 0; m < 4; ++m) {
                const size_t off = (size_t)(u.pm * BM + ai * HALF + wr * 64 + m * 16 + fr) * 512 + ch0;
                const f32x4 p = acc[ai][0][m][0] * acc[ai][0][m][1], ab = acc[ai][1][m][0], ff = acc[ai][1][m][1];
                u32x2 w; w.x = cvt_pk_bf16(p[0], p[1]); w.y = cvt_pk_bf16(p[2], p[3]); *(u32x2*)(PB + off) = w;
                w.x = cvt_pk_bf16(ab[0], ab[1]); w.y = cvt_pk_bf16(ab[2], ab[3]); *(u32x2*)(AB + off) = w;
                w.x = cvt_pk_bf16(ff[0], ff[1]); w.y = cvt_pk_bf16(ff[2], ff[3]); *(u32x2*)(FB + off) = w;
            }
    }
};
struct EpiRes {
    static constexpr bool PERM = false, AFTER_DRAIN = false;
    const float* rin_lat; const float* rin_ctx; float* out_lat; float* out_ctx; const float* gate;
    __device__ __forceinline__ void operator()(const f32x4 (&acc)[2][2][4][2], const Unit& u, int wr, int wc, int fr, int fq) const {
        const int col0 = u.pn * BM + wc * 32 + 4 * fq;
        const int grp = u.pm < 32 ? 0 : (u.pm < 64 ? 1 : 2);
        const float* gp = gate + grp * 6144 + col0;
        const bool lat = u.pm < 64;
        const float* ri = lat ? rin_lat + (size_t)u.pm * BM * 1024 : rin_ctx + (size_t)(u.pm - 64) * BM * 1024;
        float* ro = lat ? out_lat + (size_t)u.pm * BM * 1024 : out_ctx + (size_t)(u.pm - 64) * BM * 1024;
        f32x4 gv[2][2];
#pragma unroll
        for (int bj = 0; bj < 2; ++bj)
#pragma unroll
            for (int n = 0; n < 2; ++n) gv[bj][n] = *(const f32x4*)(gp + bj * HALF + n * 16);
#pragma unroll
        for (int ai = 0; ai < 2; ++ai)
#pragma unroll
            for (int m = 0; m < 4; ++m) { const size_t off = (size_t)(ai * HALF + wr * 64 + m * 16 + fr) * 1024 + col0;
#pragma unroll
                for (int bj = 0; bj < 2; ++bj)
#pragma unroll
                    for (int n = 0; n < 2; ++n) { const f32x4 r = *(const f32x4*)(ri + off + bj * HALF + n * 16); *(f32x4*)(ro + off + bj * HALF + n * 16) = r + gv[bj][n] * acc[ai][bj][m][n]; } }
    }
};
struct EpiRelu2 {
    static constexpr bool PERM = true, AFTER_DRAIN = false;
    bf16_t* O; int ldc;
    __device__ __forceinline__ void operator()(const f32x4 (&acc)[2][2][4][2], const Unit& u, int wr, int wc, int fr, int fq) const {
        const int row0 = u.pm * BM + wr * 64 + fr, col0 = u.pn * BM + wc * 32 + 8 * fq;
#pragma unroll
        for (int ai = 0; ai < 2; ++ai)
#pragma unroll
            for (int m = 0; m < 4; ++m) { bf16_t* rowp = O + (size_t)(row0 + ai * HALF + m * 16) * ldc + col0;
#pragma unroll
                for (int bj = 0; bj < 2; ++bj) { f32x4 v0 = acc[ai][bj][m][0], v1 = acc[ai][bj][m][1];
#pragma unroll
                    for (int e = 0; e < 4; ++e) { const float a = fmaxf(v0[e], 0.f), b = fmaxf(v1[e], 0.f); v0[e] = a * a; v1[e] = b * b; }
                    u32x4 w; w.x = cvt_pk_bf16(v0[0], v0[1]); w.y = cvt_pk_bf16(v0[2], v0[3]); w.z = cvt_pk_bf16(v1[0], v1[1]); w.w = cvt_pk_bf16(v1[2], v1[3]);
                    *(u32x4*)(rowp + bj * HALF) = w; } }
    }
};
struct EpiQkv {
    static constexpr bool PERM = true, AFTER_DRAIN = false;
    bf16_t* QKV; size_t part_stride; const float* gains;
    __device__ __forceinline__ void operator()(const f32x4 (&acc)[2][2][4][2], const Unit& u, int wr, int wc, int fr, int fq) const {
        const int part = u.pn >> 2, head = (u.pn & 3) * 4 + wc;
        bf16_t* base = QKV + (size_t)part * part_stride + head * 64 + 8 * fq;
        const bool nrm = part < 2;
        f32x4 gn[2][2];
#pragma unroll
        for (int bj = 0; bj < 2; ++bj)
#pragma unroll
            for (int n = 0; n < 2; ++n) gn[bj][n] = *(const f32x4*)(gains + (part & 1) * 64 + 32 * bj + 8 * fq + 4 * n);
#pragma unroll
        for (int ai = 0; ai < 2; ++ai)
#pragma unroll
            for (int m = 0; m < 4; ++m) {
                f32x4 v[2][2];
#pragma unroll
                for (int bj = 0; bj < 2; ++bj)
#pragma unroll
                    for (int n = 0; n < 2; ++n) v[bj][n] = acc[ai][bj][m][n];
                float ss = 0.f;
#pragma unroll
                for (int bj = 0; bj < 2; ++bj)
#pragma unroll
                    for (int n = 0; n < 2; ++n) ss += (v[bj][n][0] * v[bj][n][0] + v[bj][n][1] * v[bj][n][1]) + (v[bj][n][2] * v[bj][n][2] + v[bj][n][3] * v[bj][n][3]);
                ss += __shfl_xor(ss, 16); ss += __shfl_xor(ss, 32);
                const float rstd = rsqrtf(ss * (1.0f / 64.0f) + 1e-6f);
#pragma unroll
                for (int bj = 0; bj < 2; ++bj)
#pragma unroll
                    for (int n = 0; n < 2; ++n) { const f32x4 t = v[bj][n] * rstd * gn[bj][n]; v[bj][n] = nrm ? t : v[bj][n]; }
                bf16_t* rowp = base + (size_t)(u.pm * BM + ai * HALF + wr * 64 + m * 16 + fr) * 1024;
#pragma unroll
                for (int bj = 0; bj < 2; ++bj) { u32x4 w; w.x = cvt_pk_bf16(v[bj][0][0], v[bj][0][1]); w.y = cvt_pk_bf16(v[bj][0][2], v[bj][0][3]); w.z = cvt_pk_bf16(v[bj][1][0], v[bj][1][1]); w.w = cvt_pk_bf16(v[bj][1][2], v[bj][1][3]);
                    *(u32x4*)(rowp + 32 * bj) = w; }
            }
    }
};
template <class Epi, class Sched, bool ALIGN_EPI = false, bool SP2 = false>
__device__ __forceinline__ void gemm_phase(PG8_LAS unsigned char* lds, const Gemm g, const Sched& S, const Epi& E) {
    const int tid = threadIdx.x, wid = __builtin_amdgcn_readfirstlane(tid >> 6), lane = tid & 63, wr = wid >> 2, wc = wid & 3, fr = lane & 15, fq = lane >> 4;
    const int K = g.K, nt = K / BK;
    unsigned voffA[2], voffB[2];
#pragma unroll
    for (int i = 0; i < 2; ++i) { int R, C; stage_rc(tid * 16 + i * 8192, R, C); const int Rb = Epi::PERM ? ((R & ~31) + perm32(R & 31)) : R;
        voffA[i] = (unsigned)(R * K + C) * 2u; voffB[i] = (unsigned)(Rb * K + C) * 2u; }
    const size_t kstep = (size_t)(BK * 2);
    const size_t hstep = (size_t)HALF * K * 2;
    const size_t tstep = 2 * hstep;
    const unsigned ldsw = (unsigned)wid * 1024u;
    const int aoff = lds_byte(wr * 64 + fr, fq * 8), boff = lds_byte(wc * 32 + fr, fq * 8);
#define PG8_SA(b, h) (((b) * 2 + (h)) * HTB)
#define PG8_SB(b, h) ((4 + (b) * 2 + (h)) * HTB)
#define PG8_STAGE(bufoff, gbase, voff) do { _Pragma("unroll") for (int _i = 0; _i < 2; ++_i) \
        __builtin_amdgcn_global_load_lds((const unsigned*)((const char*)(gbase) + (voff)[_i]), (PG8_LAS unsigned*)(lds + (bufoff) + ldsw + _i * 8192), 16, 0, 0); } while (0)
#define PG8_LDA(dst, b, h) do { _Pragma("unroll") for (int m = 0; m < 4; ++m) _Pragma("unroll") for (int k = 0; k < 2; ++k) dst[m][k] = *(const PG8_LAS bf16x8*)(lds + PG8_SA(b, h) + aoff + m * 2048 + k * 1024); } while (0)
#define PG8_LDB(dst, b, h) do { _Pragma("unroll") for (int n = 0; n < 2; ++n) _Pragma("unroll") for (int k = 0; k < 2; ++k) dst[n][k] = *(const PG8_LAS bf16x8*)(lds + PG8_SB(b, h) + boff + n * 2048 + k * 1024); } while (0)
#define PG8_MMA(ai, bj, At, Bt) do { __builtin_amdgcn_s_setprio(1); _Pragma("unroll") for (int m = 0; m < 4; ++m) _Pragma("unroll") for (int n = 0; n < 2; ++n) _Pragma("unroll") for (int k = 0; k < 2; ++k) \
        acc[ai][bj][m][n] = __builtin_amdgcn_mfma_f32_16x16x32_bf16(Bt[n][k], At[m][k], acc[ai][bj][m][n], 0, 0, 0); __builtin_amdgcn_s_setprio(0); } while (0)
#define PG8_WAIT_V(n) asm volatile("s_waitcnt vmcnt(" #n ")" ::: "memory")
#define PG8_WAIT_L(n) asm volatile("s_waitcnt lgkmcnt(" #n ")" ::: "memory")
#define PG8_BAR __builtin_amdgcn_s_barrier()
#define PG8_SCHED __builtin_amdgcn_sched_barrier(0)
    Unit cur, nxt; int ui = 0;
    if (!S.next(0, cur)) return;
    f32x4 acc[2][2][4][2];
#pragma unroll
    for (int a = 0; a < 2; ++a)
#pragma unroll
        for (int b = 0; b < 2; ++b)
#pragma unroll
            for (int m = 0; m < 4; ++m)
#pragma unroll
                for (int n = 0; n < 2; ++n) acc[a][b][m][n] = (f32x4){0.f, 0.f, 0.f, 0.f};
    bf16x8 At[4][2], B0[2][2], B1[2][2];
    const char* cA = (const char*)g.A + (size_t)cur.pm * tstep; const char* cB = (const char*)g.Bt + (size_t)cur.pn * tstep;
    S.a_ready(cur);
    if constexpr (SP2) {
        PG8_STAGE(PG8_SB(0, 0), cB, voffB); PG8_STAGE(PG8_SB(0, 1), cB + hstep, voffB); PG8_STAGE(PG8_SA(0, 0), cA, voffA); PG8_STAGE(PG8_SA(0, 1), cA + hstep, voffA);
        if (wr == 1) PG8_BAR;
        PG8_WAIT_V(2); PG8_BAR;
        PG8_STAGE(PG8_SB(1, 0), cB + kstep, voffB); PG8_STAGE(PG8_SA(1, 0), cA + kstep, voffA); PG8_STAGE(PG8_SB(1, 1), cB + hstep + kstep, voffB);
        PG8_WAIT_V(6); PG8_BAR;
    } else {
        PG8_STAGE(PG8_SB(0, 0), cB, voffB); PG8_STAGE(PG8_SA(0, 0), cA, voffA); PG8_STAGE(PG8_SB(0, 1), cB + hstep, voffB); PG8_STAGE(PG8_SA(0, 1), cA + hstep, voffA);
        if (wr == 1) PG8_BAR;
        PG8_WAIT_V(4); PG8_BAR;
        PG8_STAGE(PG8_SB(1, 0), cB + kstep, voffB); PG8_STAGE(PG8_SA(1, 0), cA + kstep, voffA); PG8_STAGE(PG8_SB(1, 1), cB + hstep + kstep, voffB);
        PG8_WAIT_V(6); PG8_BAR;
    }
    for (;;) {
        const bool has_next = S.next(ui + 1, nxt);
        const char* nA = has_next ? (const char*)g.A + (size_t)nxt.pm * tstep : cA; const char* nB = has_next ? (const char*)g.Bt + (size_t)nxt.pn * tstep : cB;
        for (int t = 0; t < nt; t += 2) {
            const bool last = (t == nt - 2);
            const char* a1 = cA + (size_t)(t + 1) * kstep;
            const char* a2 = last ? nA : cA + (size_t)(t + 2) * kstep; const char* b2 = last ? nB : cB + (size_t)(t + 2) * kstep;
            const char* a3 = a2 + kstep; const char* b3 = b2 + kstep;
            if (last && has_next) S.a_ready(nxt);
            if constexpr (SP2) {
            PG8_LDB(B0, 0, 0); PG8_LDB(B1, 0, 1); PG8_SCHED; PG8_LDA(At, 0, 0); PG8_STAGE(PG8_SA(1, 1), a1 + hstep, voffA);
            PG8_WAIT_V(8); PG8_WAIT_L(0); PG8_BAR; PG8_MMA(0, 0, At, B0); PG8_MMA(0, 1, At, B1); PG8_BAR; PG8_SCHED;
            PG8_LDA(At, 0, 1); PG8_STAGE(PG8_SB(0, 0), b2, voffB); PG8_STAGE(PG8_SB(0, 1), b2 + hstep, voffB); PG8_STAGE(PG8_SA(0, 0), a2, voffA);
            PG8_WAIT_V(8); PG8_WAIT_L(0); PG8_BAR; PG8_MMA(1, 0, At, B0); PG8_MMA(1, 1, At, B1); PG8_BAR; PG8_SCHED;
            PG8_LDB(B0, 1, 0); PG8_LDB(B1, 1, 1); PG8_SCHED; PG8_LDA(At, 1, 0); PG8_STAGE(PG8_SA(0, 1), a2 + hstep, voffA);
            PG8_WAIT_V(8); PG8_WAIT_L(0); PG8_BAR; PG8_MMA(0, 0, At, B0); PG8_MMA(0, 1, At, B1); PG8_BAR; PG8_SCHED;
            PG8_LDA(At, 1, 1); PG8_STAGE(PG8_SB(1, 0), b3, voffB); PG8_STAGE(PG8_SB(1, 1), b3 + hstep, voffB); PG8_STAGE(PG8_SA(1, 0), a3, voffA);
            PG8_WAIT_V(8); PG8_WAIT_L(0); PG8_BAR; PG8_MMA(1, 0, At, B0); PG8_MMA(1, 1, At, B1); PG8_BAR; PG8_SCHED;
            } else {
            PG8_LDB(B0, 0, 0); PG8_SCHED; PG8_LDA(At, 0, 0); PG8_STAGE(PG8_SA(1, 1), a1 + hstep, voffA);
            PG8_WAIT_L(8); PG8_BAR; PG8_WAIT_L(0); PG8_MMA(0, 0, At, B0); PG8_BAR; PG8_SCHED;
            PG8_LDB(B1, 0, 1); PG8_STAGE(PG8_SB(0, 0), b2, voffB);
            PG8_BAR; PG8_WAIT_L(0); PG8_MMA(0, 1, At, B1); PG8_BAR;
            PG8_LDA(At, 0, 1); PG8_STAGE(PG8_SA(0, 0), a2, voffA);
            PG8_BAR; PG8_WAIT_L(0); PG8_MMA(1, 0, At, B0); PG8_BAR; PG8_SCHED;
            PG8_STAGE(PG8_SB(0, 1), b2 + hstep, voffB);
            PG8_WAIT_V(6); PG8_BAR; PG8_MMA(1, 1, At, B1); PG8_BAR;
            PG8_LDB(B0, 1, 0); PG8_SCHED; PG8_LDA(At, 1, 0); PG8_STAGE(PG8_SA(0, 1), a2 + hstep, voffA);
            PG8_WAIT_L(8); PG8_BAR; PG8_WAIT_L(0); PG8_MMA(0, 0, At, B0); PG8_BAR; PG8_SCHED;
            PG8_LDB(B1, 1, 1); PG8_STAGE(PG8_SB(1, 0), b3, voffB);
            PG8_BAR; PG8_WAIT_L(0); PG8_MMA(0, 1, At, B1); PG8_BAR;
            PG8_LDA(At, 1, 1); PG8_STAGE(PG8_SA(1, 0), a3, voffA);
            PG8_BAR; PG8_WAIT_L(0); PG8_MMA(1, 0, At, B0); PG8_BAR; PG8_SCHED;
            PG8_STAGE(PG8_SB(1, 1), b3 + hstep, voffB);
            PG8_WAIT_V(6); PG8_BAR; PG8_MMA(1, 1, At, B1); PG8_BAR;
            }
        }
        if constexpr (ALIGN_EPI) { if (wr == 0) PG8_BAR; }
        if constexpr (!Epi::AFTER_DRAIN) { E(acc, cur, wr, wc, fr, fq); S.done(cur); }
        if (!has_next) break;
#pragma unroll
        for (int a = 0; a < 2; ++a)
#pragma unroll
            for (int b = 0; b < 2; ++b)
#pragma unroll
                for (int m = 0; m < 4; ++m)
#pragma unroll
                    for (int n = 0; n < 2; ++n) acc[a][b][m][n] = (f32x4){0.f, 0.f, 0.f, 0.f};
        cur = nxt; cA = nA; cB = nB; ++ui;
        if constexpr (ALIGN_EPI) { if (wr == 1) PG8_BAR; }
    }
    PG8_WAIT_V(0);
    if constexpr (!ALIGN_EPI) { if (wr == 0) PG8_BAR; }
    PG8_BAR;
    if constexpr (Epi::AFTER_DRAIN) { E.fused(acc, cur, wr, wc, fr, fq, lds, wid, lane); S.done(cur); }
#undef PG8_SA
#undef PG8_SB
#undef PG8_STAGE
#undef PG8_LDA
#undef PG8_LDB
#undef PG8_MMA
#undef PG8_WAIT_V
#undef PG8_WAIT_L
#undef PG8_BAR
#undef PG8_SCHED
}
}
#define GAS __attribute__((address_space(1)))
#define LAS __attribute__((address_space(3)))
typedef unsigned short bf16;
typedef unsigned v4u __attribute__((ext_vector_type(4)));
typedef float f32x4 __attribute__((ext_vector_type(4)));
typedef short bf16x8 __attribute__((ext_vector_type(8)));
typedef GAS unsigned gu32;
typedef GAS unsigned long long gu64;
#define RLX_AGENT __ATOMIC_RELAXED, __HIP_MEMORY_SCOPE_AGENT
#define LDS_WAIT() asm volatile("s_waitcnt lgkmcnt(0)" ::: "memory")
#define VM_WAIT() asm volatile("s_waitcnt vmcnt(0)" ::: "memory")
__device__ __forceinline__ unsigned long long rt() { return __builtin_amdgcn_s_memrealtime(); }
__device__ __forceinline__ unsigned f2bf(float f) { unsigned u = __builtin_bit_cast(unsigned, f); return (u + 0x7fffu + ((u >> 16) & 1u)) >> 16; }
__device__ __forceinline__ unsigned pk2(float lo, float hi) { return f2bf(lo) | (f2bf(hi) << 16); }
#define XB_TMO      128
#define XB_XCNT(j)  (256  + 64 * (j))
#define XB_XSUB(j)  (1280 + 64 * (j))
#define XB_XGEN(j)  (2304 + 64 * (j))
#define XB_TOP      3328
#define XB_TOPGEN   3392
#define XCD_BAR_WORDS 3456
#define XB_SPIN_CAP (1u << 18)

__device__ __forceinline__ unsigned xb_ld(unsigned* p)              { return __hip_atomic_load(p, __ATOMIC_RELAXED, __HIP_MEMORY_SCOPE_AGENT); }
__device__ __forceinline__ unsigned xb_add(unsigned* p, unsigned v) { return __hip_atomic_fetch_add(p, v, __ATOMIC_RELAXED, __HIP_MEMORY_SCOPE_AGENT); }
__device__ __forceinline__ unsigned xb_xcc_id() { return (unsigned)__builtin_amdgcn_s_getreg((3 << 11) | 20) & 0xFu; }
#define XB_SPIN(cond, bar) do { unsigned _sp = 0; while (cond) { __builtin_amdgcn_s_sleep(1); \
    if ((++_sp & 255u) == 0u) { if (xb_ld(&(bar)[XB_TMO])) break; if (_sp > XB_SPIN_CAP) { atomicAdd(&(bar)[XB_TMO], 1u); break; } } } } while (0)

struct XcdBarrier {
    unsigned* bar; unsigned x;
    volatile LAS unsigned* st;
};

__device__ __forceinline__ XcdBarrier xcd_barrier_post(unsigned* bar, volatile LAS unsigned* st) {
    XcdBarrier b; b.bar = bar; b.x = xb_xcc_id(); b.st = st;
    if (threadIdx.x == 0) (void)xb_add(&bar[XB_XCNT(b.x)], 1u);
    return b;
}
__device__ __forceinline__ void xcd_barrier_complete(unsigned* bar, unsigned x, unsigned& nloc, unsigned& nx) {
    const unsigned G = gridDim.x * gridDim.y * gridDim.z;
    unsigned sum, cnt, mine, sp = 0u;
    for (;;) {
        sum = 0u; cnt = 0u; mine = 0u;
#pragma unroll
        for (unsigned j = 0; j < 16; ++j) { const unsigned c = xb_ld(&bar[XB_XCNT(j)]); sum += c; cnt += (c > 0u) ? 1u : 0u; mine = (j == x) ? c : mine; }
        if (sum == G) break;
        __builtin_amdgcn_s_sleep(1);
        if ((++sp & 255u) == 0u) { if (xb_ld(&bar[XB_TMO])) break; if (sp > XB_SPIN_CAP) { atomicAdd(&bar[XB_TMO], 1u); break; } }
    }
    nloc = mine > 0u ? mine : 1u; nx = cnt > 0u ? cnt : 1u;
}

__device__ __forceinline__ void xcd_barrier(const XcdBarrier& b) {
    asm volatile("s_waitcnt vmcnt(0)" ::: "memory");
    __syncthreads();
    if (threadIdx.x == 0) {
        unsigned* bar = b.bar;
        __builtin_amdgcn_s_waitcnt(0);
        unsigned nloc = b.st[0], nx = b.st[1];
        if (nloc == 0u) { xcd_barrier_complete(bar, b.x, nloc, nx); b.st[0] = nloc; b.st[1] = nx; }
        const unsigned old = xb_add(&bar[XB_XSUB(b.x)], 1u);
        const unsigned gen = old / nloc;
        if (old + 1u == (gen + 1u) * nloc) {
            __builtin_amdgcn_fence(__ATOMIC_RELEASE, "agent");
            asm volatile("s_waitcnt vmcnt(0)" ::: "memory");
            const unsigned og = xb_add(&bar[XB_TOP], 1u);
            const unsigned tg = og / nx;
            if (og + 1u == (tg + 1u) * nx) xb_add(&bar[XB_TOPGEN], 1u);
            else XB_SPIN(xb_ld(&bar[XB_TOPGEN]) == tg, bar);
            __builtin_amdgcn_fence(__ATOMIC_ACQUIRE, "agent");
            xb_add(&bar[XB_XGEN(b.x)], 1u);
            asm volatile("s_waitcnt vmcnt(0)" ::: "memory");
        } else {
            XB_SPIN(xb_ld(&bar[XB_XGEN(b.x)]) == gen, bar);
            __builtin_amdgcn_fence(__ATOMIC_ACQUIRE, "agent");
            asm volatile("s_waitcnt vmcnt(0)" ::: "memory");
        }
    }
    __syncthreads();
}
constexpr int NWAVES = 8, NTHR = 512;
constexpr int D = 1024, SEQ = 8192, CTXL = 256, MLAT = 16384, MCTX = 512, MTOT = MLAT + MCTX, FF = 4096, NH = 16, HD = 64, KMIX = 1536;
constexpr float EPS = 1e-6f;
constexpr float QSCALE = 0.125f * 1.4426950408889634f;
constexpr float LOG2E = 1.4426950408889634f;
#ifndef TRIG_OFF
#define TRIG_OFF (1 * MiB + 256 * 1024)
#endif
#ifndef ARE_MIB
#define ARE_MIB 139
#endif
constexpr size_t MiB = 1u << 20;
constexpr size_t WS_CTL = 0, CTL_ZERO_BYTES = 1 * MiB;
constexpr size_t WS_MOD = 1 * MiB;
constexpr size_t WS_GAINS = 1 * MiB + 192 * 1024;
constexpr size_t WS_TRIG = TRIG_OFF;
constexpr size_t WS_WIN = 4 * MiB, WS_WOUT0 = 8 * MiB, WS_W1_0 = 12 * MiB, WS_W2_0 = 20 * MiB, WS_WQKV = 28 * MiB, WS_WOUT1 = 34 * MiB, WS_W1_1 = 36 * MiB, WS_W2_1 = 44 * MiB;
constexpr size_t WS_XN = 52 * MiB;
constexpr size_t WS_CTXS = 86 * MiB;
constexpr size_t WS_PB = 88 * MiB, WS_AB = 105 * MiB, WS_FB = 122 * MiB, WS_ARE = ARE_MIB * MiB, WS_AIM = (ARE_MIB + 16) * MiB, WS_MIXIN = 171 * MiB;
constexpr size_t WS_HB = 88 * MiB;
constexpr size_t WS_QB = 88 * MiB, WS_KB = 121 * MiB, WS_VB = 154 * MiB, WS_OB = 187 * MiB;
constexpr size_t WS_END = 256 * MiB;
static_assert(WS_MIXIN + (size_t)MTOT * KMIX * 2 <= WS_END && WS_HB + (size_t)MTOT * FF * 2 <= WS_END && WS_OB + (size_t)MLAT * D * 2 <= WS_END, "ws map");
constexpr int CW_BAR = 4096;
constexpr int RING_OFF = 0, RING_BYTES = 131072;
constexpr int LDS_BYTES = 163840;
constexpr int LDSCTL_OFF = LDS_BYTES - 512, MISC_OFF = LDSCTL_OFF + 320;

struct Ctx {
    LAS unsigned char* lds; int tid, lane, wave, gw, ngw, gt, ngt, G;
};

__device__ __forceinline__ float wave_sum(float v) {
#pragma unroll
    for (int o = 1; o < 64; o <<= 1) v += __shfl_xor(v, o);
    return v;
}
__device__ __forceinline__ float wave_max(float v) {
#pragma unroll
    for (int o = 1; o < 64; o <<= 1) v = fmaxf(v, __shfl_xor(v, o));
    return v;
}
__device__ __forceinline__ float bf2f(unsigned short h) { return __builtin_bit_cast(float, (unsigned)h << 16); }
__device__ __forceinline__ void unpack8(const v4u w, float (&f)[8]) {
    f[0] = __builtin_bit_cast(float, w.x << 16); f[1] = __builtin_bit_cast(float, w.x & 0xffff0000u);
    f[2] = __builtin_bit_cast(float, w.y << 16); f[3] = __builtin_bit_cast(float, w.y & 0xffff0000u);
    f[4] = __builtin_bit_cast(float, w.z << 16); f[5] = __builtin_bit_cast(float, w.z & 0xffff0000u);
    f[6] = __builtin_bit_cast(float, w.w << 16); f[7] = __builtin_bit_cast(float, w.w & 0xffff0000u);
}
__device__ __forceinline__ v4u pack8(const float (&f)[8]) { v4u o; o.x = pk2(f[0], f[1]); o.y = pk2(f[2], f[3]); o.z = pk2(f[4], f[5]); o.w = pk2(f[6], f[7]); return o; }

__device__ __forceinline__ int rowmap(int code, int n) {
    if (code == 1) {
        const int part = n >> 9, ch = n & 511, pn = ch >> 6, w = ch & 63, wc = w >> 4, fq = (w >> 2) & 3, e = w & 3, bj = part >> 1, nn = part & 1;
        return 256 * pn + 128 * bj + 32 * wc + 16 * nn + 4 * fq + e;
    }
    if (code == 2) {
        const int pn = n >> 8, w = n & 255, wc = w >> 6, bj = (w >> 5) & 1, x = w & 31;
        return 256 * pn + 128 * bj + 32 * wc + x;
    }
    return n;
}
__device__ __forceinline__ void transpose_item(const float* W, int N, bf16* WT, int KP, int koff, int code, LAS float* scr, int item, int lane) {
    const int nblk = N / 32, kb = item / nblk, nb = item % nblk, k0 = 64 * kb, n0 = 32 * nb;
#pragma unroll 8
    for (int i = 0; i < 32; ++i) { const int kk = 2 * i + (lane >> 5); scr[kk * 33 + (lane & 31)] = W[(size_t)(k0 + kk) * N + n0 + (lane & 31)]; }
    LDS_WAIT(); asm volatile("" ::: "memory");
    const int c = lane & 7;
#pragma unroll
    for (int j = 0; j < 4; ++j) { const int n = (lane >> 3) + 8 * j; const LAS float* s = scr + (8 * c) * 33 + n;
        v4u o; o.x = pk2(s[0 * 33], s[1 * 33]); o.y = pk2(s[2 * 33], s[3 * 33]); o.z = pk2(s[4 * 33], s[5 * 33]); o.w = pk2(s[6 * 33], s[7 * 33]);
        *(GAS v4u*)(WT + (size_t)rowmap(code, n0 + n) * KP + koff + k0 + 8 * c) = o; }
    LDS_WAIT(); asm volatile("" ::: "memory");
}
__device__ __forceinline__ void fold_item(const float* Wout, bf16* WT, LAS float* scr, const LAS float* tab, int item, int lane) {
    const int g = item >> 5, nb = item & 31, k0 = 512 + 64 * g, n0 = 32 * nb;
#pragma unroll 8
    for (int i = 0; i < 32; ++i) { const int kk = 2 * i + (lane >> 5); scr[kk * 33 + (lane & 31)] = Wout[(size_t)(k0 + kk) * 1024 + n0 + (lane & 31)]; }
    LDS_WAIT(); asm volatile("" ::: "memory");
    const int c8 = lane & 7;
    for (int j = 0; j < 4; ++j) { const int n = (lane >> 3) + 8 * j;
        float aP[8], aQ[8];
#pragma unroll
        for (int i = 0; i < 8; ++i) { aP[i] = 0.f; aQ[i] = 0.f; }
        for (int m = 0; m < 64; ++m) { const float x = scr[m * 33 + n];
#pragma unroll
            for (int i = 0; i < 8; ++i) { const int idx = ((8 * c8 + i) * m) & 63; aP[i] += tab[idx] * x; aQ[i] -= tab[64 + idx] * x; } }
        *(GAS v4u*)(WT + (size_t)(n0 + n) * KMIX + 512 + 64 * g + 8 * c8) = pack8(aP);
        *(GAS v4u*)(WT + (size_t)(n0 + n) * KMIX + 1024 + 64 * g + 8 * c8) = pack8(aQ); }
    LDS_WAIT(); asm volatile("" ::: "memory");
}

struct In { const float *x, *c, *ctx, *c_ctx, *ada_w, *ada_b, *nmix_g, *nmlp_g, *w1, *w2, *w_in, *conv_w, *w_out0, *w_qkv, *q_g, *k_g, *rpb, *w_out1; };

__device__ __forceinline__ void p0_prologue(const Ctx& F, const In& I, unsigned char* ws) {
    { float* trig = (float*)(ws + WS_TRIG); for (int j = F.gt; j < 8192; j += F.ngt) { trig[2 * j] = cospif((float)j * (1.0f / 4096.0f)); trig[2 * j + 1] = sinpif((float)j * (1.0f / 4096.0f)); } }
    if (F.gt < 128) ((float*)(ws + WS_GAINS))[F.gt] = F.gt < 64 ? I.q_g[F.gt] * QSCALE : I.k_g[F.gt - 64];
    if (blockIdx.x < 192) {
        LAS float* sc = (LAS float*)(F.lds);
        LAS float* red = (LAS float*)(F.lds + 12288);
        for (int i = F.tid; i < 3 * 1024; i += NTHR) { const int g = i >> 10, k = i & 1023; const float xv = g < 2 ? I.c[g * 1024 + k] : I.c_ctx[k]; sc[i] = xv / (1.0f + __expf(-xv)); }
        __syncthreads();
        const int layer = blockIdx.x / 96, cg = blockIdx.x % 96, col = cg * 64 + F.lane;
        const float* W = I.ada_w + (size_t)layer * 1024 * 6144 + col;
        float a0 = 0.f, a1 = 0.f, a2 = 0.f;
#pragma unroll 16
        for (int kk = 0; kk < 128; ++kk) { const int k = F.wave * 128 + kk; const float wv = W[(size_t)k * 6144]; a0 += sc[k] * wv; a1 += sc[1024 + k] * wv; a2 += sc[2048 + k] * wv; }
        red[(F.wave * 3 + 0) * 64 + F.lane] = a0; red[(F.wave * 3 + 1) * 64 + F.lane] = a1; red[(F.wave * 3 + 2) * 64 + F.lane] = a2;
        __syncthreads();
        if (F.wave < 3) { float s = I.ada_b[layer * 6144 + col];
#pragma unroll
            for (int w = 0; w < 8; ++w) s += red[(w * 3 + F.wave) * 64 + F.lane];
            ((float*)(ws + WS_MOD))[(layer * 3 + F.wave) * 6144 + col] = s; }
        __syncthreads();
    }
    LAS float* scr = (LAS float*)(F.lds + RING_OFF + F.wave * 16384);
    LAS float* tab = scr + 2112;
    tab[F.lane] = cospif((float)F.lane * (1.0f / 32.0f)); tab[64 + F.lane] = sinpif((float)F.lane * (1.0f / 32.0f));
    LDS_WAIT(); asm volatile("" ::: "memory");
    constexpr int I_WIN = 16 * 64, I_WO0 = 8 * 32, I_FOLD = 8 * 32, I_W1 = 16 * 128, I_W2 = 64 * 32, I_QKV = 16 * 96, I_WO1 = 16 * 32;
    constexpr int NITEMS = I_WIN + I_WO0 + I_FOLD + 2 * I_W1 + 2 * I_W2 + I_QKV + I_WO1;
    for (int it = F.gw; it < NITEMS; it += F.ngw) {
        int r = it;
        if (r < I_WIN) { transpose_item(I.w_in, 2048, (bf16*)(ws + WS_WIN), 1024, 0, 1, scr, r, F.lane); continue; } r -= I_WIN;
        if (r < I_WO0) { transpose_item(I.w_out0, 1024, (bf16*)(ws + WS_WOUT0), KMIX, 0, 0, scr, r, F.lane); continue; } r -= I_WO0;
        if (r < I_FOLD) { fold_item(I.w_out0, (bf16*)(ws + WS_WOUT0), scr, tab, r, F.lane); continue; } r -= I_FOLD;
        if (r < I_W1) { transpose_item(I.w1, 4096, (bf16*)(ws + WS_W1_0), 1024, 0, 0, scr, r, F.lane); continue; } r -= I_W1;
        if (r < I_W1) { transpose_item(I.w1 + (size_t)1024 * 4096, 4096, (bf16*)(ws + WS_W1_1), 1024, 0, 0, scr, r, F.lane); continue; } r -= I_W1;
        if (r < I_W2) { transpose_item(I.w2, 1024, (bf16*)(ws + WS_W2_0), 4096, 0, 0, scr, r, F.lane); continue; } r -= I_W2;
        if (r < I_W2) { transpose_item(I.w2 + (size_t)4096 * 1024, 1024, (bf16*)(ws + WS_W2_1), 4096, 0, 0, scr, r, F.lane); continue; } r -= I_W2;
        if (r < I_QKV) { transpose_item(I.w_qkv, 3072, (bf16*)(ws + WS_WQKV), 1024, 0, 2, scr, r, F.lane); continue; } r -= I_QKV;
        transpose_item(I.w_out1, 1024, (bf16*)(ws + WS_WOUT1), 1024, 0, 0, scr, r, F.lane);
    }
}

__device__ __forceinline__ void norm_phase(const Ctx& F, const float* lat, const float* ctx, int nrows, const float* gain, const float* mod, bf16* XN) {
    for (int m = F.gw; m < nrows; m += F.ngw) {
        const float* xrow = m < MLAT ? lat + (size_t)m * D : ctx + (size_t)(m - MLAT) * D;
        const int grp = m < SEQ ? 0 : (m < MLAT ? 1 : 2);
        const float* mg = mod + grp * 6144;
        const GAS f32x4* xr = (const GAS f32x4*)xrow + F.lane;
        f32x4 v[4]; float s = 0.f;
#pragma unroll
        for (int j = 0; j < 4; ++j) { v[j] = xr[64 * j]; s += (v[j].x * v[j].x + v[j].y * v[j].y) + (v[j].z * v[j].z + v[j].w * v[j].w); }
        const float rstd = rsqrtf(wave_sum(s) * (1.f / D) + EPS);
        GAS unsigned long long* o8 = (GAS unsigned long long*)(XN + (size_t)m * D) + F.lane;
#pragma unroll
        for (int j = 0; j < 4; ++j) { const int col = 4 * F.lane + 256 * j;
            const f32x4 gg = *(const f32x4*)(gain + col), sh = *(const f32x4*)(mg + col), sc = *(const f32x4*)(mg + 1024 + col);
            const f32x4 y = (v[j] * rstd) * gg * (sc + 1.0f) + sh;
            o8[64 * j] = (unsigned long long)pk2(y.x, y.y) | ((unsigned long long)pk2(y.z, y.w) << 32); }
    }
}

__device__ __forceinline__ void conv_phase(const Ctx& F, const bf16* PB, const bf16* AB, const float* cw, bf16* MIX) {
    for (int it = F.gt; it < MTOT * 64; it += F.ngt) {
        const int row = it >> 6, ch = (it & 63) * 8;
        int t, L; if (row < MLAT) { t = row & (SEQ - 1); L = SEQ; } else { t = (row - MLAT) & (CTXL - 1); L = CTXL; }
        float pc[8], pp[8], pn[8], ab[8], o[8];
        unpack8(*(const GAS v4u*)(PB + (size_t)row * 512 + ch), pc);
        unpack8(*(const GAS v4u*)(AB + (size_t)row * 512 + ch), ab);
        if (t > 0) unpack8(*(const GAS v4u*)(PB + (size_t)(row - 1) * 512 + ch), pp); else { for (int i = 0; i < 8; ++i) pp[i] = 0.f; }
        if (t < L - 1) unpack8(*(const GAS v4u*)(PB + (size_t)(row + 1) * 512 + ch), pn); else { for (int i = 0; i < 8; ++i) pn[i] = 0.f; }
#pragma unroll
        for (int i = 0; i < 8; ++i) o[i] = ab[i] * (cw[ch + i] * pp[i] + cw[512 + ch + i] * pc[i] + cw[1024 + ch + i] * pn[i]);
        *(GAS v4u*)(MIX + (size_t)row * KMIX + ch) = pack8(o);
    }
}
__device__ __forceinline__ void fft1_simple(const Ctx& F, const bf16* FB, const float* trig, bf16* ARE, bf16* AIM) {
    for (int it = F.gt; it < (1 << 20); it += F.ngt) {
        const int ch = (it & 63) * 8, t2 = (it >> 6) & 63, k1 = (it >> 12) & 127, b = it >> 19;
        float ar[8], ai[8];
#pragma unroll
        for (int i = 0; i < 8; ++i) { ar[i] = 0.f; ai[i] = 0.f; }
        for (int t1 = 0; t1 < 128; ++t1) {
            float x[8]; unpack8(*(const GAS v4u*)(FB + (size_t)(b * SEQ + 64 * t1 + t2) * 512 + ch), x);
            const int idx = (64 * k1 * t1) & 8191; const float c = trig[2 * idx], s = trig[2 * idx + 1];
#pragma unroll
            for (int i = 0; i < 8; ++i) { ar[i] += c * x[i]; ai[i] += s * x[i]; }
        }
        const int idx = (k1 * t2) & 8191; const float c = trig[2 * idx], s = trig[2 * idx + 1];
        float br[8], bi[8];
#pragma unroll
        for (int i = 0; i < 8; ++i) { br[i] = ar[i] * c - ai[i] * s; bi[i] = ar[i] * s + ai[i] * c; }
        const size_t off = ((size_t)(b * 128 + k1) * 64 + t2) * 512 + ch;
        *(GAS v4u*)(ARE + off) = pack8(br); *(GAS v4u*)(AIM + off) = pack8(bi);
    }
}
__device__ __forceinline__ void fftc_simple(const Ctx& F, const bf16* FB, const float* trig, bf16* MIX) {
    for (int it = F.gt; it < 2 * 256 * 64; it += F.ngt) {
        const int ch = (it & 63) * 8, k = (it >> 6) & 255, b = it >> 14;
        float p[8], q[8];
#pragma unroll
        for (int i = 0; i < 8; ++i) { p[i] = 0.f; q[i] = 0.f; }
        for (int t = 0; t < 256; ++t) {
            float x[8]; unpack8(*(const GAS v4u*)(FB + (size_t)(MLAT + b * 256 + t) * 512 + ch), x);
            const int idx = (32 * k * t) & 8191; const float c = trig[2 * idx], s = trig[2 * idx + 1];
#pragma unroll
            for (int i = 0; i < 8; ++i) { p[i] += c * x[i]; q[i] += s * x[i]; }
        }
#pragma unroll
        for (int i = 0; i < 8; ++i) { p[i] *= (1.0f / 128.0f); q[i] *= (1.0f / 128.0f); }
        const size_t off = (size_t)(MLAT + b * 256 + k) * KMIX + ch;
        *(GAS v4u*)(MIX + off + 512) = pack8(p); *(GAS v4u*)(MIX + off + 1024) = pack8(q);
    }
}
__device__ __forceinline__ void fft2_simple(const Ctx& F, const bf16* ARE, const bf16* AIM, const float* trig, bf16* MIX) {
    for (int it = F.gt; it < (1 << 20); it += F.ngt) {
        const int ch = (it & 63) * 8, k1 = (it >> 6) & 127, k2 = (it >> 13) & 63, b = it >> 19;
        float p[8], q[8];
#pragma unroll
        for (int i = 0; i < 8; ++i) { p[i] = 0.f; q[i] = 0.f; }
        for (int t2 = 0; t2 < 64; ++t2) {
            const size_t off = ((size_t)(b * 128 + k1) * 64 + t2) * 512 + ch;
            float br[8], bi[8]; unpack8(*(const GAS v4u*)(ARE + off), br); unpack8(*(const GAS v4u*)(AIM + off), bi);
            const int idx = (128 * k2 * t2) & 8191; const float c = trig[2 * idx], s = trig[2 * idx + 1];
#pragma unroll
            for (int i = 0; i < 8; ++i) { p[i] += c * br[i] - s * bi[i]; q[i] += s * br[i] + c * bi[i]; }
        }
        const float sc = 0.0013810679320049757f;
#pragma unroll
        for (int i = 0; i < 8; ++i) { p[i] *= sc; q[i] *= sc; }
        const size_t off = (size_t)(b * SEQ + k1 + 128 * k2) * KMIX + ch;
        *(GAS v4u*)(MIX + off + 512) = pack8(p); *(GAS v4u*)(MIX + off + 1024) = pack8(q);
    }
}
__device__ __forceinline__ void na_simple(const Ctx& F, const bf16* QB, const bf16* KB, const bf16* VB, const float* rpb, bf16* OB) {
    LAS float* pbuf = (LAS float*)(F.lds + F.wave * 16384);
    for (int task = F.gw; task < MLAT * NH; task += F.ngw) {
        const int h = task & 15, row = task >> 4, b = row >> 13, t = row & 8191, r = t >> 6, c = t & 63;
        const int rs = min(max(r - 4, 0), 120), cs = min(max(c - 8, 0), 48);
        float q[64];
#pragma unroll
        for (int i = 0; i < 8; ++i) { float tmp[8]; unpack8(*(const GAS v4u*)(QB + (size_t)row * D + h * 64 + 8 * i), tmp);
#pragma unroll
            for (int e = 0; e < 8; ++e) q[8 * i + e] = tmp[e]; }
        float sv[6]; float mx = -3.0e38f;
#pragma unroll
        for (int i = 0; i < 6; ++i) { const int j = F.lane + 64 * i; size_t krow; float bias = 0.f;
            if (j < 128) { const int rr = rs + (j >> 4), cc = cs + (j & 15); krow = (size_t)b * SEQ + rr * 64 + cc; bias = rpb[(h * 15 + (rr - r + 7)) * 31 + (cc - c + 15)] * LOG2E; }
            else krow = (size_t)MLAT + b * 256 + (j - 128);
            float dot = 0.f;
#pragma unroll
            for (int i8 = 0; i8 < 8; ++i8) { float kk[8]; unpack8(*(const GAS v4u*)(KB + krow * D + h * 64 + 8 * i8), kk);
#pragma unroll
                for (int e = 0; e < 8; ++e) dot += q[8 * i8 + e] * kk[e]; }
            sv[i] = dot + bias; mx = fmaxf(mx, sv[i]); }
        mx = wave_max(mx);
        float l = 0.f;
#pragma unroll
        for (int i = 0; i < 6; ++i) { const float p = exp2f(sv[i] - mx); l += p; pbuf[F.lane + 64 * i] = p; }
        l = wave_sum(l);
        LDS_WAIT(); asm volatile("" ::: "memory");
        float o = 0.f;
        for (int j = 0; j < 384; ++j) { size_t krow;
            if (j < 128) krow = (size_t)b * SEQ + (rs + (j >> 4)) * 64 + cs + (j & 15); else krow = (size_t)MLAT + b * 256 + (j - 128);
            o += pbuf[j] * bf2f(VB[krow * D + h * 64 + F.lane]); }
        OB[(size_t)row * D + h * 64 + F.lane] = (bf16)f2bf(o / l);
        LDS_WAIT(); asm volatile("" ::: "memory");
    }
}
typedef short v4i16_t __attribute__((ext_vector_type(4)));
constexpr int NA_KC = 0, NA_VC = 32768, NA_RING = 65536, NA_NSLOT = 11, NA_TAB = NA_RING + NA_NSLOT * 8192;
__device__ __forceinline__ int na_rs(int r) { return min(max(r - 4, 0), 120); }
__device__ __forceinline__ void na_fast(const Ctx& F, const bf16* QB, const bf16* KB, const bf16* VB, const float* rpb, bf16* OB) {
    LAS unsigned char* lds = F.lds;
    const int lane = F.lane, w = F.wave, i = lane & 15, g = lane >> 4, q_ = i >> 2, p_ = i & 3;
    for (int sw = F.gw >> 3; sw < 256; sw += F.G) {
        const int bh = sw >> 3, b = bh >> 4, h = bh & 15, band = sw & 7;
        for (int id = F.tid; id < 2048; id += NTHR) { const int key = id >> 3, c = id & 7; const size_t src = (size_t)(MLAT + b * 256 + key) * D + h * 64 + c * 8;
            const v4u kv = *(const GAS v4u*)(KB + src), vv = *(const GAS v4u*)(VB + src);
            *(LAS v4u*)(lds + NA_KC + key * 128 + ((c ^ ((key >> 1) & 7)) << 4)) = kv;
            *(LAS v4u*)(lds + NA_VC + key * 128 + ((c ^ (((key >> 1) & 3) << 1)) << 4)) = vv; }
        for (int j = F.tid; j < 465; j += NTHR) ((LAS float*)(lds + NA_TAB))[j] = rpb[h * 465 + j] * LOG2E;
        const bf16* Vbh = VB + (size_t)b * SEQ * D + h * 64;
#define NA_DMA_ROWS(rlo, rhi) do { const int _n = ((rhi) - (rlo)) * 8; for (int _p = w; _p < _n; _p += NWAVES) { const int _rr = (rlo) + (_p >> 3), _j = _p & 7, _col = 8 * _j + (lane >> 3), _c = (lane & 7) ^ (((_col >> 1) & 3) << 1); \
            __builtin_amdgcn_global_load_lds((const unsigned*)(Vbh + (size_t)(_rr * 64 + _col) * D + _c * 8), (LAS unsigned*)(lds + NA_RING + (_rr % NA_NSLOT) * 8192 + _j * 1024), 16, 0, 0); } } while (0)
        { const int r0 = 16 * band; const int lo = na_rs(r0), hi = na_rs(r0 + 1) + 8; NA_DMA_ROWS(lo, hi); }
        asm volatile("s_waitcnt vmcnt(0)" ::: "memory"); __syncthreads();
        for (int pi = 0; pi < 8; ++pi) {
            const int r0 = 16 * band + 2 * pi;
            if (pi < 7) { const int hi = na_rs(r0 + 1) + 8, nhi = na_rs(r0 + 3) + 8; NA_DMA_ROWS(hi, nhi); }
            const int r = r0 + (w >> 2), c0 = 16 * (w & 3), u0 = min(max(c0 - 8, 0), 32), rs_ = na_rs(r);
            const bf16* qp = QB + (size_t)(b * SEQ + r * 64 + c0 + i) * D + h * 64 + 16 * g;
            const bf16x8 qf0 = *(const GAS bf16x8*)qp, qf1 = *(const GAS bf16x8*)(qp + 8);
            f32x4 S[32];
            const bf16* kp = KB + (size_t)(b * SEQ + rs_ * 64 + u0 + i) * D + h * 64 + 16 * g;
#pragma unroll
            for (int T = 0; T < 16; ++T) { const bf16* kt = kp + (size_t)((T >> 1) * 64 + 16 * (T & 1)) * D;
                const bf16x8 a0 = *(const GAS bf16x8*)kt, a1 = *(const GAS bf16x8*)(kt + 8);
                f32x4 acc = __builtin_amdgcn_mfma_f32_16x16x32_bf16(a0, qf0, (f32x4){0.f, 0.f, 0.f, 0.f}, 0, 0, 0);
                S[T] = __builtin_amdgcn_mfma_f32_16x16x32_bf16(a1, qf1, acc, 0, 0, 0); }
#pragma unroll
            for (int T = 0; T < 16; ++T) { const int key = 16 * T + i, x = (key >> 1) & 7;
                const bf16x8 a0 = *(const LAS bf16x8*)(lds + NA_KC + key * 128 + (((2 * g) ^ x) << 4)), a1 = *(const LAS bf16x8*)(lds + NA_KC + key * 128 + (((2 * g + 1) ^ x) << 4));
                f32x4 acc = __builtin_amdgcn_mfma_f32_16x16x32_bf16(a0, qf0, (f32x4){0.f, 0.f, 0.f, 0.f}, 0, 0, 0);
                S[16 + T] = __builtin_amdgcn_mfma_f32_16x16x32_bf16(a1, qf1, acc, 0, 0, 0); }
            { const int c = c0 + i, cs = min(max(c - 8, 0), 48); const LAS float* tab = (const LAS float*)(lds + NA_TAB);
#pragma unroll
              for (int T = 0; T < 16; ++T) { const int ro = (rs_ + (T >> 1)) - r + 7;
#pragma unroll
                for (int e = 0; e < 4; ++e) { const int cc = u0 + 16 * (T & 1) + 4 * g + e; const bool ok = (unsigned)(cc - cs) < 16u; const float bv = tab[ro * 31 + cc - c + 15];
                    S[T][e] = ok ? S[T][e] + bv : -1.0e30f; } } }
            float mx = -3.0e38f;
#pragma unroll
            for (int T = 0; T < 32; ++T) mx = fmaxf(fmaxf(mx, fmaxf(S[T][0], S[T][1])), fmaxf(S[T][2], S[T][3]));
            mx = fmaxf(mx, __shfl_xor(mx, 16)); mx = fmaxf(mx, __shfl_xor(mx, 32));
            float l = 0.f;
#pragma unroll
            for (int T = 0; T < 32; ++T) {
#pragma unroll
                for (int e = 0; e < 4; ++e) { S[T][e] = __builtin_amdgcn_exp2f(S[T][e] - mx); l += S[T][e]; } }
            l += __shfl_xor(l, 16); l += __shfl_xor(l, 32);
            f32x4 O[4];
#pragma unroll
            for (int m = 0; m < 4; ++m) O[m] = (f32x4){0.f, 0.f, 0.f, 0.f};
            const int swz = ((2 * g + (q_ >> 1)) & 3) << 1;
            int voff[4];
#pragma unroll
            for (int m = 0; m < 4; ++m) voff[m] = (((2 * m + (p_ >> 1)) ^ swz) << 4) + (p_ & 1) * 8;
#pragma unroll
            for (int t = 0; t < 16; ++t) {
                v4u pw; pw.x = pg8::cvt_pk_bf16(S[2 * t][0], S[2 * t][1]); pw.y = pg8::cvt_pk_bf16(S[2 * t][2], S[2 * t][3]); pw.z = pg8::cvt_pk_bf16(S[2 * t + 1][0], S[2 * t + 1][1]); pw.w = pg8::cvt_pk_bf16(S[2 * t + 1][2], S[2 * t + 1][3]);
                const bf16x8 pb = __builtin_bit_cast(bf16x8, pw);
                int rowb;
                if (t < 8) rowb = NA_RING + ((rs_ + t) % NA_NSLOT) * 8192 + (u0 + 4 * g + q_) * 128; else rowb = NA_VC + (32 * (t - 8) + 4 * g + q_) * 128;
#pragma unroll
                for (int m = 0; m < 4; ++m) {
                    const v4i16_t v0 = __builtin_amdgcn_ds_read_tr16_b64_v4i16((LAS v4i16_t*)(lds + rowb + voff[m]));
                    const v4i16_t v1 = __builtin_amdgcn_ds_read_tr16_b64_v4i16((LAS v4i16_t*)(lds + rowb + 2048 + voff[m]));
                    const bf16x8 va = (bf16x8){v0[0], v0[1], v0[2], v0[3], v1[0], v1[1], v1[2], v1[3]};
                    O[m] = __builtin_amdgcn_mfma_f32_16x16x32_bf16(va, pb, O[m], 0, 0, 0); }
            }
            const float rl = 1.0f / l;
            bf16* op = OB + (size_t)(b * SEQ + r * 64 + c0 + i) * D + h * 64 + 4 * g;
#pragma unroll
            for (int m = 0; m < 4; ++m) { pg8::u32x2 o2; o2.x = pg8::cvt_pk_bf16(O[m][0] * rl, O[m][1] * rl); o2.y = pg8::cvt_pk_bf16(O[m][2] * rl, O[m][3] * rl); *(GAS pg8::u32x2*)(op + 16 * m) = o2; }
            asm volatile("s_waitcnt vmcnt(0)" ::: "memory"); __syncthreads();
        }
#undef NA_DMA_ROWS
    }
}
#ifndef DFT_X1
#define DFT_X1 0
#endif
#ifndef DFT_X3
#define DFT_X3 0
#endif
constexpr size_t WS_T1C = 2 * MiB, WS_T1S = WS_T1C + 32768, WS_T2C = WS_T1C + 65536, WS_T2S = WS_T2C + 8192, WS_T3C = 2 * MiB + 131072, WS_T3S = WS_T3C + 131072;
__device__ __forceinline__ void build_dft_tables(const Ctx& F, unsigned char* ws) {
    bf16* t1c = (bf16*)(ws + WS_T1C); bf16* t1s = (bf16*)(ws + WS_T1S); bf16* t2c = (bf16*)(ws + WS_T2C); bf16* t2s = (bf16*)(ws + WS_T2S); bf16* t3c = (bf16*)(ws + WS_T3C); bf16* t3s = (bf16*)(ws + WS_T3S);
    for (int j = F.gt; j < 16384 + 4096 + 65536; j += F.ngt) {
        if (j < 16384) { const int k = j >> 7, t = j & 127; const float a = (float)((k * t) & 127) * (1.0f / 64.0f); t1c[j] = (bf16)f2bf(cospif(a)); t1s[j] = (bf16)f2bf(sinpif(a)); }
        else if (j < 16384 + 4096) { const int jj = j - 16384, k = jj >> 6, t = jj & 63; const float a = (float)((k * t) & 63) * (1.0f / 32.0f); t2c[jj] = (bf16)f2bf(cospif(a)); t2s[jj] = (bf16)f2bf(sinpif(a)); }
        else { const int jj = j - 16384 - 4096, k = jj >> 8, t = jj & 255; const float a = (float)((k * t) & 255) * (1.0f / 128.0f); t3c[jj] = (bf16)f2bf(cospif(a)); t3s[jj] = (bf16)f2bf(sinpif(a)); }
    }
}
__device__ __forceinline__ int dft_h(int row) { return ((row & 3) | (((row >> 3) & 1) << 2)) << 1; }
template <int ROWB> __device__ __forceinline__ void dft_load_tile(LAS unsigned char* lds, int xoff, const bf16* src0, size_t rstride, int nrows, int wave, int lane) {
    constexpr int RPP = 1024 / ROWB, CPR = ROWB / 16; const int pieces = nrows / RPP;
#if DFT_NO_DMA
    for (int p = wave; p < pieces; p += NWAVES) { const int row = p * RPP + lane / CPR, c = (lane % CPR) ^ dft_h(row);
        const v4u v = *(const GAS v4u*)(src0 + (size_t)row * rstride + c * 8); *(LAS v4u*)(lds + xoff + p * 1024 + lane * 16) = v; }
#else
    for (int p = wave; p < pieces; p += NWAVES) { const int row = p * RPP + lane / CPR, c = (lane % CPR) ^ dft_h(row);
        __builtin_amdgcn_global_load_lds((const unsigned*)(src0 + (size_t)row * rstride + c * 8), (LAS unsigned*)(lds + xoff + p * 1024), 16, 0, 0); }
#endif
}
template <int T_LEN> __device__ __forceinline__ void dft_load_table(LAS unsigned char* lds, int toff, const bf16* tab, int nk, int tid) {
    constexpr int CPR = T_LEN / 8, TP = T_LEN * 2 + 16;
    for (int id = tid; id < nk * CPR; id += NTHR) { const int row = id / CPR, c = id % CPR; *(LAS v4u*)(lds + toff + row * TP + c * 16) = *(const GAS v4u*)(tab + (size_t)row * T_LEN + c * 8); }
}
typedef short v4i16_t2 __attribute__((ext_vector_type(4)));
__device__ __forceinline__ bf16x8 dft_afrag(LAS unsigned char* lds, int addr0, int addr1) {
    const v4i16_t2 v0 = __builtin_amdgcn_ds_read_tr16_b64_v4i16((LAS v4i16_t2*)(lds + addr0)), v1 = __builtin_amdgcn_ds_read_tr16_b64_v4i16((LAS v4i16_t2*)(lds + addr1));
    return (bf16x8){v0[0], v0[1], v0[2], v0[3], v1[0], v1[1], v1[2], v1[3]};
}
template <int T_LEN, int ROWB, int MT, int NT>
__device__ __forceinline__ void dft_real_core(LAS unsigned char* lds, int xoff, int tcoff, int tsoff, int wave, int lane, int nt0, f32x4 (&accC)[MT][NT], f32x4 (&accS)[MT][NT], const bf16* gtc = nullptr, const bf16* gts = nullptr) {
    constexpr int TP = T_LEN * 2 + 16;
    const int i = lane & 15, g = lane >> 4, q_ = i >> 2, p_ = i & 3, h = (q_ | ((g & 1) << 2)) << 1;
#pragma unroll
    for (int mt = 0; mt < MT; ++mt)
#pragma unroll
        for (int nt = 0; nt < NT; ++nt) { accC[mt][nt] = (f32x4){0.f, 0.f, 0.f, 0.f}; accS[mt][nt] = (f32x4){0.f, 0.f, 0.f, 0.f}; }
#pragma unroll
    for (int s = 0; s < T_LEN / 32; ++s) {
        bf16x8 A[MT];
#pragma unroll
        for (int mt = 0; mt < MT; ++mt) { const int c = (16 * MT * wave + 16 * mt) / 8 + (p_ >> 1); const int row0 = 32 * s + 8 * g + q_;
            const int a0 = xoff + row0 * ROWB + ((c ^ h) << 4) + (p_ & 1) * 8; A[mt] = dft_afrag(lds, a0, a0 + 4 * ROWB); }
#pragma unroll
        for (int nt = 0; nt < NT; ++nt) { const int boff = (16 * (nt0 + nt) + i) * TP + (32 * s + 8 * g) * 2;
#if DFT_X1
            const bf16x8 bc = *(const GAS bf16x8*)(gtc + (size_t)(16 * (nt0 + nt) + i) * T_LEN + 32 * s + 8 * g), bs = *(const GAS bf16x8*)(gts + (size_t)(16 * (nt0 + nt) + i) * T_LEN + 32 * s + 8 * g);
#else
            const bf16x8 bc = *(const LAS bf16x8*)(lds + tcoff + boff), bs = *(const LAS bf16x8*)(lds + tsoff + boff);
#endif
#pragma unroll
            for (int mt = 0; mt < MT; ++mt) { accC[mt][nt] = __builtin_amdgcn_mfma_f32_16x16x32_bf16(A[mt], bc, accC[mt][nt], 0, 0, 0); accS[mt][nt] = __builtin_amdgcn_mfma_f32_16x16x32_bf16(A[mt], bs, accS[mt][nt], 0, 0, 0); } }
    }
}
__device__ __forceinline__ void st4(bf16* p, const f32x4 v) { pg8::u32x2 w; w.x = pg8::cvt_pk_bf16(v[0], v[1]); w.y = pg8::cvt_pk_bf16(v[2], v[3]); *(GAS pg8::u32x2*)p = w; }
#ifndef DFT_X1
#define DFT_X1 0
#endif
#ifndef DFT_X3
#define DFT_X3 0
#endif
#ifndef S1NT
#define S1NT 4
#endif
constexpr int DFT_X = 0, DFT_X2 = 32768, DFT_TC = 65536, DFT_TS = DFT_TC + 34816;

__device__ __forceinline__ void fft1_fast(const Ctx& F, const bf16* FB, const float* trig, const unsigned char* ws, bf16* ARE, bf16* AIM, bf16* MIX) {
    LAS unsigned char* lds = F.lds; const int lane = F.lane, w = F.wave, i = lane & 15, g = lane >> 4;
    bool tables = false;
#if !FFTL_SIMPLE
    for (int task = F.gw >> 3; task < 256; task += F.G) {
        const int b = task >> 7, t2 = (task >> 1) & 63, half = task & 1;
        if (!tables) { dft_load_table<128>(lds, DFT_TC, (const bf16*)(ws + WS_T1C), 128, F.tid); dft_load_table<128>(lds, DFT_TS, (const bf16*)(ws + WS_T1S), 128, F.tid); tables = true; }
        dft_load_tile<512>(lds, DFT_X, FB + (size_t)(b * SEQ + t2) * 512 + half * 256, (size_t)64 * 512, 128, w, lane);
        asm volatile("s_waitcnt vmcnt(0)" ::: "memory"); __syncthreads();
        for (int pass = 0; pass < 8 / S1NT; ++pass) {
        f32x4 aC[2][S1NT], aS[2][S1NT];
        dft_real_core<128, 512, 2, S1NT>(lds, DFT_X, DFT_TC, DFT_TS, w, lane, S1NT * pass, aC, aS, (const bf16*)(ws + WS_T1C), (const bf16*)(ws + WS_T1S));
#pragma unroll
        for (int nt = 0; nt < S1NT; ++nt) { const int k1 = 16 * (S1NT * pass + nt) + i, idx = (k1 * t2) & 8191;
#if DFT_X3
            const float c = cospif((float)idx * (1.0f / 4096.0f)), s = sinpif((float)idx * (1.0f / 4096.0f));
#else
            const float c = trig[2 * idx], s = trig[2 * idx + 1];
#endif
            const size_t off = ((size_t)(b * 128 + k1) * 64 + t2) * 512 + half * 256 + 32 * w + 4 * g;
#pragma unroll
            for (int mt = 0; mt < 2; ++mt) { st4(ARE + off + 16 * mt, aC[mt][nt] * c - aS[mt][nt] * s); st4(AIM + off + 16 * mt, aC[mt][nt] * s + aS[mt][nt] * c); } }
        }
        __syncthreads();
    }
#endif
#if !FFTC_SIMPLE
    for (int task = F.gw >> 3; task < 32; task += F.G) {
        const int b = task >> 4, cq = (task >> 2) & 3, kb = task & 3;
        __syncthreads();
        dft_load_table<256>(lds, DFT_TC, (const bf16*)(ws + WS_T3C) + (size_t)kb * 64 * 256, 64, F.tid); dft_load_table<256>(lds, DFT_TS, (const bf16*)(ws + WS_T3S) + (size_t)kb * 64 * 256, 64, F.tid);
        dft_load_tile<256>(lds, DFT_X, FB + (size_t)(MLAT + b * 256) * 512 + cq * 128, (size_t)512, 256, w, lane);
        asm volatile("s_waitcnt vmcnt(0)" ::: "memory"); __syncthreads();
        f32x4 aC[1][4], aS[1][4];
        dft_real_core<256, 256, 1, 4>(lds, DFT_X, DFT_TC, DFT_TS, w, lane, 0, aC, aS);
#pragma unroll
        for (int nt = 0; nt < 4; ++nt) { const int k = 64 * kb + 16 * nt + i; const size_t off = (size_t)(MLAT + b * 256 + k) * KMIX + cq * 128 + 16 * w + 4 * g;
            st4(MIX + off + 512, aC[0][nt] * (1.0f / 128.0f)); st4(MIX + off + 1024, aS[0][nt] * (1.0f / 128.0f)); }
        __syncthreads();
    }
#endif
}
__device__ __forceinline__ void fft2_fast(const Ctx& F, const bf16* ARE, const bf16* AIM, const unsigned char* ws, bf16* MIX) {
    LAS unsigned char* lds = F.lds; const int lane = F.lane, w = F.wave, i = lane & 15, g = lane >> 4, q_ = i >> 2, p_ = i & 3, h = (q_ | ((g & 1) << 2)) << 1;
    constexpr int TP = 64 * 2 + 16;
    bool tables = false;
    for (int task = F.gw >> 3; task < 512; task += F.G) {
        const int b = task >> 8, k1 = (task >> 1) & 127, half = task & 1;
        if (!tables) { dft_load_table<64>(lds, DFT_TC, (const bf16*)(ws + WS_T2C), 64, F.tid); dft_load_table<64>(lds, DFT_TS, (const bf16*)(ws + WS_T2S), 64, F.tid); tables = true; }
        const size_t src = (size_t)(b * 128 + k1) * 64 * 512 + half * 256;
        dft_load_tile<512>(lds, DFT_X, ARE + src, (size_t)512, 64, w, lane); dft_load_tile<512>(lds, DFT_X2, AIM + src, (size_t)512, 64, w, lane);
        asm volatile("s_waitcnt vmcnt(0)" ::: "memory"); __syncthreads();
        f32x4 aP[2][4], aQ[2][4];
#pragma unroll
        for (int mt = 0; mt < 2; ++mt)
#pragma unroll
            for (int nt = 0; nt < 4; ++nt) { aP[mt][nt] = (f32x4){0.f, 0.f, 0.f, 0.f}; aQ[mt][nt] = (f32x4){0.f, 0.f, 0.f, 0.f}; }
#pragma unroll
        for (int s = 0; s < 2; ++s) {
            bf16x8 Ar[2], Ai[2];
#pragma unroll
            for (int mt = 0; mt < 2; ++mt) { const int c = (32 * w + 16 * mt) / 8 + (p_ >> 1); const int row0 = 32 * s + 8 * g + q_;
                const int a0 = row0 * 512 + ((c ^ h) << 4) + (p_ & 1) * 8; Ar[mt] = dft_afrag(lds, DFT_X + a0, DFT_X + a0 + 2048); Ai[mt] = dft_afrag(lds, DFT_X2 + a0, DFT_X2 + a0 + 2048); }
#pragma unroll
            for (int nt = 0; nt < 4; ++nt) { const int boff = (16 * nt + i) * TP + (32 * s + 8 * g) * 2;
                const bf16x8 bc = *(const LAS bf16x8*)(lds + DFT_TC + boff), bs = *(const LAS bf16x8*)(lds + DFT_TS + boff);
                const bf16x8 bns = __builtin_bit_cast(bf16x8, __builtin_bit_cast(v4u, bs) ^ 0x80008000u);
#pragma unroll
                for (int mt = 0; mt < 2; ++mt) {
                    aP[mt][nt] = __builtin_amdgcn_mfma_f32_16x16x32_bf16(Ar[mt], bc, aP[mt][nt], 0, 0, 0); aP[mt][nt] = __builtin_amdgcn_mfma_f32_16x16x32_bf16(Ai[mt], bns, aP[mt][nt], 0, 0, 0);
                    aQ[mt][nt] = __builtin_amdgcn_mfma_f32_16x16x32_bf16(Ar[mt], bs, aQ[mt][nt], 0, 0, 0); aQ[mt][nt] = __builtin_amdgcn_mfma_f32_16x16x32_bf16(Ai[mt], bc, aQ[mt][nt], 0, 0, 0); } }
        }
        const float sc = 0.0013810679320049757f;
#pragma unroll
        for (int nt = 0; nt < 4; ++nt) { const int k2 = 16 * nt + i; const size_t off = (size_t)(b * SEQ + k1 + 128 * k2) * KMIX + half * 256 + 32 * w + 4 * g;
#pragma unroll
            for (int mt = 0; mt < 2; ++mt) { st4(MIX + off + 512 + 16 * mt, aP[mt][nt] * sc); st4(MIX + off + 1024 + 16 * mt, aQ[mt][nt] * sc); } }
        __syncthreads();
    }
}
#ifndef FFTC_SIMPLE
#define FFTC_SIMPLE 0
#endif
#ifndef DFT_NO_DMA
#define DFT_NO_DMA 0
#endif
#ifndef FFTL_PRE
#define FFTL_PRE 0
#endif
#ifndef FFTL_BOTH
#define FFTL_BOTH 0
#endif
#ifndef FFTL_SIMPLE
#define FFTL_SIMPLE 0
#endif
#ifndef FFT1_SIMPLE
#define FFT1_SIMPLE 0
#endif
#ifndef FFT2_SIMPLE
#define FFT2_SIMPLE 0
#endif
#ifndef NA_SIMPLE
#define NA_SIMPLE 0
#endif
#ifndef MK_MULTI
#define MK_MULTI 0
#endif
constexpr int NPHASE = 16;
struct Args { const float* in[18]; float* out; unsigned char* ws; int ph_lo, ph_hi; };
__global__ void __launch_bounds__(NTHR, 2) hyb_fwd(Args args) {
    extern __shared__ __attribute__((aligned(16))) unsigned char lds_raw[];
    Ctx F; F.lds = (LAS unsigned char*)lds_raw; F.tid = threadIdx.x; F.lane = F.tid & 63; F.wave = __builtin_amdgcn_readfirstlane(F.tid >> 6); F.G = gridDim.x;
    { const int bx = blockIdx.x; const int vcu = (F.G % 8 == 0) ? (bx % 8) * (F.G / 8) + bx / 8 : bx;
      F.gw = vcu * NWAVES + F.wave; F.ngw = F.G * NWAVES; F.gt = vcu * NTHR + F.tid; F.ngt = F.G * NTHR; }
    unsigned char* ws = args.ws;
    In I; I.x = args.in[0]; I.c = args.in[1]; I.ctx = args.in[2]; I.c_ctx = args.in[3]; I.ada_w = args.in[4]; I.ada_b = args.in[5]; I.nmix_g = args.in[6]; I.nmlp_g = args.in[7];
    I.w1 = args.in[8]; I.w2 = args.in[9]; I.w_in = args.in[10]; I.conv_w = args.in[11]; I.w_out0 = args.in[12]; I.w_qkv = args.in[13]; I.q_g = args.in[14]; I.k_g = args.in[15]; I.rpb = args.in[16]; I.w_out1 = args.in[17];
    float* out = args.out;
    for (int u = F.tid; u < (LDS_BYTES - LDSCTL_OFF) / 4; u += NTHR) ((LAS unsigned*)(F.lds + LDSCTL_OFF))[u] = 0u;
    __syncthreads();
    XcdBarrier bar; bar.bar = (unsigned*)(ws + WS_CTL) + CW_BAR; bar.x = 0; bar.st = nullptr;
    if (!MK_MULTI) bar = xcd_barrier_post((unsigned*)(ws + WS_CTL) + CW_BAR, (volatile LAS unsigned*)(F.lds + MISC_OFF) + 8);
    const int lo = args.ph_lo, hi = args.ph_hi;
#define IN(k) (lo <= (k) && (k) < hi)
#define SEAM(k) do { if (IN(k) && IN((k) + 1)) xcd_barrier(bar); } while (0)
    const float* MOD = (const float*)(ws + WS_MOD);
    const float* trig = (const float*)(ws + WS_TRIG);
    bf16* XN = (bf16*)(ws + WS_XN); float* CTXS = (float*)(ws + WS_CTXS);
    bf16 *PB = (bf16*)(ws + WS_PB), *AB = (bf16*)(ws + WS_AB), *FB = (bf16*)(ws + WS_FB), *ARE = (bf16*)(ws + WS_ARE), *AIM = (bf16*)(ws + WS_AIM), *MIX = (bf16*)(ws + WS_MIXIN);
    bf16 *HB = (bf16*)(ws + WS_HB), *QB = (bf16*)(ws + WS_QB), *KB = (bf16*)(ws + WS_KB), *VB = (bf16*)(ws + WS_VB), *OB = (bf16*)(ws + WS_OB);
    LAS unsigned char* ring = F.lds + RING_OFF;
    const int bid = (int)blockIdx.x;

    if (IN(0)) { build_dft_tables(F, ws); p0_prologue(F, I, ws); } SEAM(0);
    if (IN(1)) { norm_phase(F, I.x, I.ctx, MTOT, I.nmix_g, MOD, XN); } SEAM(1);
    if (IN(2)) { pg8::Gemm g{XN, (const bf16*)(ws + WS_WIN), MTOT, 2048, 1024}; pg8::StaticOrder S; S.init(MTOT, 2048, F.G, bid);
        pg8::EpiWin E{PB, AB, FB}; pg8::gemm_phase<pg8::EpiWin, pg8::StaticOrder, true, true>(ring, g, S, E); } SEAM(2);
    #if FFT1_SIMPLE
    if (IN(3)) { conv_phase(F, PB, AB, I.conv_w, MIX); fft1_simple(F, FB, trig, ARE, AIM); fftc_simple(F, FB, trig, MIX); } SEAM(3);
#else
    if (IN(3)) {
#if FFTL_PRE
        fft1_simple(F, FB, trig, ARE, AIM); asm volatile("s_waitcnt vmcnt(0)" ::: "memory"); xcd_barrier(bar);
#endif
        fft1_fast(F, FB, trig, ws, ARE, AIM, MIX); conv_phase(F, PB, AB, I.conv_w, MIX);
#if FFTC_SIMPLE
        fftc_simple(F, FB, trig, MIX);
#endif
#if FFTL_SIMPLE || FFTL_BOTH
        fft1_simple(F, FB, trig, ARE, AIM);
#endif
    } SEAM(3);
#endif
#if FFT2_SIMPLE
    if (IN(4)) { fft2_simple(F, ARE, AIM, trig, MIX); } SEAM(4);
#else
    if (IN(4)) { fft2_fast(F, ARE, AIM, ws, MIX); } SEAM(4);
#endif
    if (IN(5)) { pg8::Gemm g{MIX, (const bf16*)(ws + WS_WOUT0), MTOT, 1024, KMIX}; pg8::StaticOrder S; S.init(MTOT, 1024, F.G, bid);
        pg8::EpiRes E{I.x, I.ctx, out, CTXS, MOD + 2048}; pg8::gemm_phase<pg8::EpiRes, pg8::StaticOrder, true, true>(ring, g, S, E); } SEAM(5);
    if (IN(6)) { norm_phase(F, out, CTXS, MTOT, I.nmlp_g, MOD + 3072, XN); } SEAM(6);
    if (IN(7)) { pg8::Gemm g{XN, (const bf16*)(ws + WS_W1_0), MTOT, FF, 1024}; pg8::StaticOrder S; S.init(MTOT, FF, F.G, bid);
        pg8::EpiRelu2 E{HB, FF}; pg8::gemm_phase<pg8::EpiRelu2, pg8::StaticOrder, true, true>(ring, g, S, E); } SEAM(7);
    if (IN(8)) { pg8::Gemm g{HB, (const bf16*)(ws + WS_W2_0), MTOT, 1024, FF}; pg8::StaticOrder S; S.init(MTOT, 1024, F.G, bid);
        pg8::EpiRes E{out, CTXS, out, CTXS, MOD + 5120}; pg8::gemm_phase<pg8::EpiRes, pg8::StaticOrder, true, true>(ring, g, S, E); } SEAM(8);
    if (IN(9)) { norm_phase(F, out, CTXS, MTOT, I.nmix_g + 1024, MOD + 18432, XN); } SEAM(9);
    if (IN(10)) { pg8::Gemm g{XN, (const bf16*)(ws + WS_WQKV), MTOT, 3072, 1024}; pg8::StaticOrder S; S.init(MTOT, 3072, F.G, bid);
        pg8::EpiQkv E{QB, (size_t)(WS_KB - WS_QB) / 2, (const float*)(ws + WS_GAINS)}; pg8::gemm_phase<pg8::EpiQkv, pg8::StaticOrder, true, true>(ring, g, S, E); } SEAM(10);
    #if NA_SIMPLE
    if (IN(11)) { na_simple(F, QB, KB, VB, I.rpb, OB); }
#else
    if (IN(11)) { na_fast(F, QB, KB, VB, I.rpb, OB); }
#endif
    SEAM(11);
    if (IN(12)) { pg8::Gemm g{OB, (const bf16*)(ws + WS_WOUT1), MLAT, 1024, 1024}; pg8::StaticOrder S; S.init(MLAT, 1024, F.G, bid);
        pg8::EpiRes E{out, CTXS, out, CTXS, MOD + 18432 + 2048}; pg8::gemm_phase<pg8::EpiRes, pg8::StaticOrder, true, true>(ring, g, S, E); } SEAM(12);
    if (IN(13)) { norm_phase(F, out, CTXS, MLAT, I.nmlp_g + 1024, MOD + 18432 + 3072, XN); } SEAM(13);
    if (IN(14)) { pg8::Gemm g{XN, (const bf16*)(ws + WS_W1_1), MLAT, FF, 1024}; pg8::StaticOrder S; S.init(MLAT, FF, F.G, bid);
        pg8::EpiRelu2 E{HB, FF}; pg8::gemm_phase<pg8::EpiRelu2, pg8::StaticOrder, true, true>(ring, g, S, E); } SEAM(14);
    if (IN(15)) { pg8::Gemm g{HB, (const bf16*)(ws + WS_W2_1), MLAT, 1024, FF}; pg8::StaticOrder S; S.init(MLAT, 1024, F.G, bid);
        pg8::EpiRes E{out, CTXS, out, CTXS, MOD + 18432 + 5120}; pg8::gemm_phase<pg8::EpiRes, pg8::StaticOrder, true, true>(ring, g, S, E); }
#undef IN
#undef SEAM
}

extern "C" void kernel_launch(void* const* d_in, const int* in_sizes, int n_in, void* d_out, int out_size, void* d_ws, size_t ws_size, hipStream_t stream) {
    static int grid = 0;
    if (grid == 0) {
        if (n_in != 18 || out_size != MLAT * D || ws_size < WS_END) { fprintf(stderr, "kernel_launch: unexpected shapes (n_in %d out %d ws %zu)\n", n_in, out_size, ws_size); grid = -1; return; }
        int dev = 0, cus = 0;
        if (hipGetDevice(&dev) != hipSuccess || hipDeviceGetAttribute(&cus, hipDeviceAttributeMultiprocessorCount, dev) != hipSuccess) { grid = -1; return; }
        if (hipFuncSetAttribute((const void*)hyb_fwd, hipFuncAttributeMaxDynamicSharedMemorySize, LDS_BYTES) != hipSuccess) { fprintf(stderr, "kernel_launch: hipFuncSetAttribute failed\n"); grid = -1; return; }
        (void)hipGetLastError();
        grid = cus;
    }
    if (grid < 0) return;
    if (hipMemsetAsync((char*)d_ws + WS_CTL, 0, CTL_ZERO_BYTES, stream) != hipSuccess) return;
    Args a{};
    for (int i = 0; i < 18; ++i) a.in[i] = (const float*)d_in[i];
    a.out = (float*)d_out; a.ws = (unsigned char*)d_ws;
#if MK_MULTI
    for (int p = 0; p < NPHASE; ++p) { a.ph_lo = p; a.ph_hi = p + 1; hipLaunchKernelGGL(hyb_fwd, dim3(grid), dim3(NTHR), LDS_BYTES, stream, a); }
#else
    a.ph_lo = 0; a.ph_hi = NPHASE; hipLaunchKernelGGL(hyb_fwd, dim3(grid), dim3(NTHR), LDS_BYTES, stream, a);
#endif
}
```

```cpp
#define DFT_X3 1
#define S1NT 2
#include <hip/hip_runtime.h>
#include <cstdio>
#include <cstdint>
namespace pg8 {
#define PG8_LAS __attribute__((address_space(3)))
typedef unsigned short bf16_t;
typedef short bf16x8 __attribute__((ext_vector_type(8)));
typedef float f32x4 __attribute__((ext_vector_type(4)));
typedef unsigned u32x4 __attribute__((ext_vector_type(4)));
constexpr int BM = 256, BK = 64, HALF = 128, HTB = HALF * BK * 2  , STAGE_BYTES = 8 * HTB, NXCD = 8, WGM = 8;

__host__ __device__ __forceinline__ int lds_byte(int r, int c) { const int st = (r >> 4) * 2 + (c >> 5), rr = r & 15, cc = c & 31, ob = rr * 64 + cc * 2; return st * 1024 + (ob ^ (((ob >> 9) & 1) << 5)); }
__host__ __device__ __forceinline__ void stage_rc(int b, int& R, int& C) { const int st = b / 1024, sb = b % 1024, swz = sb ^ (((sb >> 9) & 1) << 5); R = (st >> 1) * 16 + swz / 64; C = (st & 1) * 32 + (swz % 64) / 2; }
__host__ __device__ __forceinline__ int perm32(int rho) { const int n = rho >> 4, i = rho & 15; return 8 * (i >> 2) + 4 * n + (i & 3); }

struct Unit { int pm, pn; };
struct Gemm { const bf16_t* A; const bf16_t* Bt; int M, N, K; };

struct StaticOrder {
    int nM, nN, nwg, G, c;
    __host__ __device__ void init(int M, int N, int G_, int c_) { nM = M / BM; nN = N / BM; nwg = nM * nN; G = G_; c = c_; }
    __host__ __device__ bool next(int i, Unit& u) const {
        const long L = (long)i * G + c; if (L >= nwg) return false;
        int wgid = (int)L; { const int q = nwg / NXCD, r = nwg % NXCD, xcd = wgid % NXCD, off = wgid / NXCD; wgid = (xcd < r ? xcd * (q + 1) : r * (q + 1) + (xcd - r) * q) + off; }
        const int nig = WGM * nN, gid = wgid / nig, fm = gid * WGM, gsz = (nM - fm) < WGM ? (nM - fm) : WGM;
        u.pm = fm + ((wgid % nig) % gsz); u.pn = (wgid % nig) / gsz; return true;
    }
    __device__ __forceinline__ void a_ready(const Unit&) const {}
    __device__ __forceinline__ void done(const Unit&) const {}
};

__device__ __forceinline__ unsigned cvt_pk_bf16(float lo, float hi) { unsigned r; asm volatile("v_cvt_pk_bf16_f32 %0, %1, %2" : "=v"(r) : "v"(lo), "v"(hi)); return r; }
typedef float f32x2 __attribute__((ext_vector_type(2)));
typedef unsigned u32x2 __attribute__((ext_vector_type(2)));
struct EpiWin {
    static constexpr bool PERM = false, AFTER_DRAIN = false;
    bf16_t *PB, *AB, *FB;
    __device__ __forceinline__ void operator()(const f32x4 (&acc)[2][2][4][2], const Unit& u, int wr, int wc, int fr, int fq) const {
        const int ch0 = u.pn * 64 + wc * 16 + fq * 4;
#pragma unroll
        for (int ai = 0; ai < 2; ++ai)
#pragma unroll
            for (int m = 0; m < 4; ++m) {
                const size_t off = (size_t)(u.pm * BM + ai * HALF + wr * 64 + m * 16 + fr) * 512 + ch0;
                const f32x4 p = acc[ai][0][m][0] * acc[ai][0][m][1], ab = acc[ai][1][m][0], ff = acc[ai][1][m][1];
                u32x2 w; w.x = cvt_pk_bf16(p[0], p[1]); w.y = cvt_pk_bf16(p[2], p[3]); *(u32x2*)(PB + off) = w;
                w.x = cvt_pk_bf16(ab[0], ab[1]); w.y = cvt_pk_bf16(ab[2], ab[3]); *(u32x2*)(AB + off) = w;
                w.x = cvt_pk_bf16(ff[0], ff[1]); w.y = cvt_pk_bf16(ff[2], ff[3]); *(u32x2*)(FB + off) = w;
            }
    }
};
struct EpiRes {
    static constexpr bool PERM = false, AFTER_DRAIN = false;
    const float* rin_lat; const float* rin_ctx; float* out_lat; float* out_ctx; const float* gate;
    __device__ __forceinline__ void operator()(const f32x4 (&acc)[2][2][4][2], const Unit& u, int wr, int wc, int fr, int fq) const {
        const int col0 = u.pn * BM + wc * 32 + 4 * fq;
        const int grp = u.pm < 32 ? 0 : (u.pm < 64 ? 1 : 2);
        const float* gp = gate + grp * 6144 + col0;
        const bool lat = u.pm < 64;
        const float* ri = lat ? rin_lat + (size_t)u.pm * BM * 1024 : rin_ctx + (size_t)(u.pm - 64) * BM * 1024;
        float* ro = lat ? out_lat + (size_t)u.pm * BM * 1024 : out_ctx + (size_t)(u.pm - 64) * BM * 1024;
        f32x4 gv[2][2];
#pragma unroll
        for (int bj = 0; bj < 2; ++bj)
#pragma unroll
            for (int n = 0; n < 2; ++n) gv[bj][n] = *(const f32x4*)(gp + bj * HALF + n * 16);
#pragma unroll
        for (int ai = 0; ai < 2; ++ai)
#pragma unroll
            for (int m = 0; m < 4; ++m) { const size_t off = (size_t)(ai * HALF + wr * 64 + m * 16 + fr) * 1024 + col0;
#pragma unroll
                for (int bj = 0; bj < 2; ++bj)
#pragma unroll
                    for (int n = 0; n < 2; ++n) { const f32x4 r = *(const f32x4*)(ri + off + bj * HALF + n * 16); *(f32x4*)(ro + off + bj * HALF + n * 16) = r + gv[bj][n] * acc[ai][bj][m][n]; } }
    }
};
struct EpiRelu2 {
    static constexpr bool PERM = true, AFTER_DRAIN = false;
    bf16_t* O; int ldc;
    __device__ __forceinline__ void operator()(const f32x4 (&acc)[2][2][4][2], const Unit& u, int wr, int wc, int fr, int fq) const {
        const int row0 = u.pm * BM + wr * 64 + fr, col0 = u.pn * BM + wc * 32 + 8 * fq;
#pragma unroll
        for (int ai = 0; ai < 2; ++ai)
#pragma unroll
            for (int m = 0; m < 4; ++m) { bf16_t* rowp = O + (size_t)(row0 + ai * HALF + m * 16) * ldc + col0;
#pragma unroll
                for (int bj = 0; bj < 2; ++bj) { f32x4 v0 = acc[ai][bj][m][0], v1 = acc[ai][bj][m][1];
#pragma unroll
                    for (int e = 0; e < 4; ++e) { const float a = fmaxf(v0[e], 0.f), b = fmaxf(v1[e], 0.f); v0[e] = a * a; v1[e] = b * b; }
                    u32x4 w; w.x = cvt_pk_bf16(v0[0], v0[1]); w.y = cvt_pk_bf16(v0[2], v0[3]); w.z = cvt_pk_bf16(v1[0], v1[1]); w.w = cvt_pk_bf16(v1[2], v1[3]);
                    *(u32x4*)(rowp + bj * HALF) = w; } }
    }
};
struct EpiQkv {
    static constexpr bool PERM = true, AFTER_DRAIN = false;
    bf16_t* QKV; size_t part_stride; const float* gains;
    __device__ __forceinline__ void operator()(const f32x4 (&acc)[2][2][4][2], const Unit& u, int wr, int wc, int fr, int fq) const {
        const int part = u.pn >> 2, head = (u.pn & 3) * 4 + wc;
        bf16_t* base = QKV + (size_t)part * part_stride + head * 64 + 8 * fq;
        const bool nrm = part < 2;
        f32x4 gn[2][2];
#pragma unroll
        for (int bj = 0; bj < 2; ++bj)
#pragma unroll
            for (int n = 0; n < 2; ++n) gn[bj][n] = *(const f32x4*)(gains + (part & 1) * 64 + 32 * bj + 8 * fq + 4 * n);
#pragma unroll
        for (int ai = 0; ai < 2; ++ai)
#pragma unroll
            for (int m = 0; m < 4; ++m) {
                f32x4 v[2][2];
#pragma unroll
                for (int bj = 0; bj < 2; ++bj)
#pragma unroll
                    for (int n = 0; n < 2; ++n) v[bj][n] = acc[ai][bj][m][n];
                float ss = 0.f;
#pragma unroll
                for (int bj = 0; bj < 2; ++bj)
#pragma unroll
                    for (int n = 0; n < 2; ++n) ss += (v[bj][n][0] * v[bj][n][0] + v[bj][n][1] * v[bj][n][1]) + (v[bj][n][2] * v[bj][n][2] + v[bj][n][3] * v[bj][n][3]);
                ss += __shfl_xor(ss, 16); ss += __shfl_xor(ss, 32);
                const float rstd = rsqrtf(ss * (1.0f / 64.0f) + 1e-6f);
#pragma unroll
                for (int bj = 0; bj < 2; ++bj)
#pragma unroll
                    for (int n = 0; n < 2; ++n) { const f32x4 t = v[bj][n] * rstd * gn[bj][n]; v[bj][n] = nrm ? t : v[bj][n]; }
                bf16_t* rowp = base + (size_t)(u.pm * BM + ai * HALF + wr * 64 + m * 16 + fr) * 1024;
#pragma unroll
                for (int bj = 0; bj < 2; ++bj) { u32x4 w; w.x = cvt_pk_bf16(v[bj][0][0], v[bj][0][1]); w.y = cvt_pk_bf16(v[bj][0][2], v[bj][0][3]); w.z = cvt_pk_bf16(v[bj][1][0], v[bj][1][1]); w.w = cvt_pk_bf16(v[bj][1][2], v[bj][1][3]);
                    *(u32x4*)(rowp + 32 * bj) = w; }
            }
    }
};
template <class Epi, class Sched, bool ALIGN_EPI = false, bool SP2 = false>
__device__ __forceinline__ void gemm_phase(PG8_LAS unsigned char* lds, const Gemm g, const Sched& S, const Epi& E) {
    const int tid = threadIdx.x, wid = __builtin_amdgcn_readfirstlane(tid >> 6), lane = tid & 63, wr = wid >> 2, wc = wid & 3, fr = lane & 15, fq = lane >> 4;
    const int K = g.K, nt = K / BK;
    unsigned voffA[2], voffB[2];
#pragma unroll
    for (int i = 0; i < 2; ++i) { int R, C; stage_rc(tid * 16 + i * 8192, R, C); const int Rb = Epi::PERM ? ((R & ~31) + perm32(R & 31)) : R;
        voffA[i] = (unsigned)(R * K + C) * 2u; voffB[i] = (unsigned)(Rb * K + C) * 2u; }
    const size_t kstep = (size_t)(BK * 2);
    const size_t hstep = (size_t)HALF * K * 2;
    const size_t tstep = 2 * hstep;
    const unsigned ldsw = (unsigned)wid * 1024u;
    const int aoff = lds_byte(wr * 64 + fr, fq * 8), boff = lds_byte(wc * 32 + fr, fq * 8);
#define PG8_SA(b, h) (((b) * 2 + (h)) * HTB)
#define PG8_SB(b, h) ((4 + (b) * 2 + (h)) * HTB)
#define PG8_STAGE(bufoff, gbase, voff) do { _Pragma("unroll") for (int _i = 0; _i < 2; ++_i) \
        __builtin_amdgcn_global_load_lds((const unsigned*)((const char*)(gbase) + (voff)[_i]), (PG8_LAS unsigned*)(lds + (bufoff) + ldsw + _i * 8192), 16, 0, 0); } while (0)
#define PG8_LDA(dst, b, h) do { _Pragma("unroll") for (int m = 0; m < 4; ++m) _Pragma("unroll") for (int k = 0; k < 2; ++k) dst[m][k] = *(const PG8_LAS bf16x8*)(lds + PG8_SA(b, h) + aoff + m * 2048 + k * 1024); } while (0)
#define PG8_LDB(dst, b, h) do { _Pragma("unroll") for (int n = 0; n < 2; ++n) _Pragma("unroll") for (int k = 0; k < 2; ++k) dst[n][k] = *(const PG8_LAS bf16x8*)(lds + PG8_SB(b, h) + boff + n * 2048 + k * 1024); } while (0)
#define PG8_MMA(ai, bj, At, Bt) do { __builtin_amdgcn_s_setprio(1); _Pragma("unroll") for (int m = 0; m < 4; ++m) _Pragma("unroll") for (int n = 0; n < 2; ++n) _Pragma("unroll") for (int k = 0; k < 2; ++k) \
        acc[ai][bj][m][n] = __builtin_amdgcn_mfma_f32_16x16x32_bf16(Bt[n][k], At[m][k], acc[ai][bj][m][n], 0, 0, 0); __builtin_amdgcn_s_setprio(0); } while (0)
#define PG8_WAIT_V(n) asm volatile("s_waitcnt vmcnt(" #n ")" ::: "memory")
#define PG8_WAIT_L(n) asm volatile("s_waitcnt lgkmcnt(" #n ")" ::: "memory")
#define PG8_BAR __builtin_amdgcn_s_barrier()
#define PG8_SCHED __builtin_amdgcn_sched_barrier(0)
    Unit cur, nxt; int ui = 0;
    if (!S.next(0, cur)) return;
    f32x4 acc[2][2][4][2];
#pragma unroll
    for (int a = 0; a < 2; ++a)
#pragma unroll
        for (int b = 0; b < 2; ++b)
#pragma unroll
            for (int m = 0; m < 4; ++m)
#pragma unroll
                for (int n = 0; n < 2; ++n) acc[a][b][m][n] = (f32x4){0.f, 0.f, 0.f, 0.f};
    bf16x8 At[4][2], B0[2][2], B1[2][2];
    const char* cA = (const char*)g.A + (size_t)cur.pm * tstep; const char* cB = (const char*)g.Bt + (size_t)cur.pn * tstep;
    S.a_ready(cur);
    if constexpr (SP2) {
        PG8_STAGE(PG8_SB(0, 0), cB, voffB); PG8_STAGE(PG8_SB(0, 1), cB + hstep, voffB); PG8_STAGE(PG8_SA(0, 0), cA, voffA); PG8_STAGE(PG8_SA(0, 1), cA + hstep, voffA);
        if (wr == 1) PG8_BAR;
        PG8_WAIT_V(2); PG8_BAR;
        PG8_STAGE(PG8_SB(1, 0), cB + kstep, voffB); PG8_STAGE(PG8_SA(1, 0), cA + kstep, voffA); PG8_STAGE(PG8_SB(1, 1), cB + hstep + kstep, voffB);
        PG8_WAIT_V(6); PG8_BAR;
    } else {
        PG8_STAGE(PG8_SB(0, 0), cB, voffB); PG8_STAGE(PG8_SA(0, 0), cA, voffA); PG8_STAGE(PG8_SB(0, 1), cB + hstep, voffB); PG8_STAGE(PG8_SA(0, 1), cA + hstep, voffA);
        if (wr == 1) PG8_BAR;
        PG8_WAIT_V(4); PG8_BAR;
        PG8_STAGE(PG8_SB(1, 0), cB + kstep, voffB); PG8_STAGE(PG8_SA(1, 0), cA + kstep, voffA); PG8_STAGE(PG8_SB(1, 1), cB + hstep + kstep, voffB);
        PG8_WAIT_V(6); PG8_BAR;
    }
    for (;;) {
        const bool has_next = S.next(ui + 1, nxt);
        const char* nA = has_next ? (const char*)g.A + (size_t)nxt.pm * tstep : cA; const char* nB = has_next ? (const char*)g.Bt + (size_t)nxt.pn * tstep : cB;
        for (int t = 0; t < nt; t += 2) {
            const bool last = (t == nt - 2);
            const char* a1 = cA + (size_t)(t + 1) * kstep;
            const char* a2 = last ? nA : cA + (size_t)(t + 2) * kstep; const char* b2 = last ? nB : cB + (size_t)(t + 2) * kstep;
            const char* a3 = a2 + kstep; const char* b3 = b2 + kstep;
            if (last && has_next) S.a_ready(nxt);
            if constexpr (SP2) {
            PG8_LDB(B0, 0, 0); PG8_LDB(B1, 0, 1); PG8_SCHED; PG8_LDA(At, 0, 0); PG8_STAGE(PG8_SA(1, 1), a1 + hstep, voffA);
            PG8_WAIT_V(8); PG8_WAIT_L(0); PG8_BAR; PG8_MMA(0, 0, At, B0); PG8_MMA(0, 1, At, B1); PG8_BAR; PG8_SCHED;
            PG8_LDA(At, 0, 1); PG8_STAGE(PG8_SB(0, 0), b2, voffB); PG8_STAGE(PG8_SB(0, 1), b2 + hstep, voffB); PG8_STAGE(PG8_SA(0, 0), a2, voffA);
            PG8_WAIT_V(8); PG8_WAIT_L(0); PG8_BAR; PG8_MMA(1, 0, At, B0); PG8_MMA(1, 1, At, B1); PG8_BAR; PG8_SCHED;
            PG8_LDB(B0, 1, 0); PG8_LDB(B1, 1, 1); PG8_SCHED; PG8_LDA(At, 1, 0); PG8_STAGE(PG8_SA(0, 1), a2 + hstep, voffA);
            PG8_WAIT_V(8); PG8_WAIT_L(0); PG8_BAR; PG8_MMA(0, 0, At, B0); PG8_MMA(0, 1, At, B1); PG8_BAR; PG8_SCHED;
            PG8_LDA(At, 1, 1); PG8_STAGE(PG8_SB(1, 0), b3, voffB); PG8_STAGE(PG8_SB(1, 1), b3 + hstep, voffB); PG8_STAGE(PG8_SA(1, 0), a3, voffA);
            PG8_WAIT_V(8); PG8_WAIT_L(0); PG8_BAR; PG8_MMA(1, 0, At, B0); PG8_MMA(1, 1, At, B1); PG8_BAR; PG8_SCHED;
            } else {
            PG8_LDB(B0, 0, 0); PG8_SCHED; PG8_LDA(At, 0, 0); PG8_STAGE(PG8_SA(1, 1), a1 + hstep, voffA);
            PG8_WAIT_L(8); PG8_BAR; PG8_WAIT_L(0); PG8_MMA(0, 0, At, B0); PG8_BAR; PG8_SCHED;
            PG8_LDB(B1, 0, 1); PG8_STAGE(PG8_SB(0, 0), b2, voffB);
            PG8_BAR; PG8_WAIT_L(0); PG8_MMA(0, 1, At, B1); PG8_BAR;
            PG8_LDA(At, 0, 1); PG8_STAGE(PG8_SA(0, 0), a2, voffA);
            PG8_BAR; PG8_WAIT_L(0); PG8_MMA(1, 0, At, B0); PG8_BAR; PG8_SCHED;
            PG8_STAGE(PG8_SB(0, 1), b2 + hstep, voffB);
            PG8_WAIT_V(6); PG8_BAR; PG8_MMA(1, 1, At, B1); PG8_BAR;
            PG8_LDB(B0, 1, 0); PG8_SCHED; PG8_LDA(At, 1, 0); PG8_STAGE(PG8_SA(0, 1), a2 + hstep, voffA);
            PG8_WAIT_L(8); PG8_BAR; PG8_WAIT_L(0); PG8_MMA(0, 0, At, B0); PG8_BAR; PG8_SCHED;
            PG8_LDB(B1, 1, 1); PG8_STAGE(PG8_SB(1, 0), b3, voffB);
            PG8_BAR; PG8_WAIT_L(0); PG8_MMA(0, 1, At, B1); PG8_BAR;
            PG8_LDA(At, 1, 1); PG8_STAGE(PG8_SA(1, 0), a3, voffA);
            PG8_BAR; PG8_WAIT_L(0); PG8_MMA(1, 0, At, B0); PG8_BAR; PG8_SCHED;
            PG8_STAGE(PG8_SB(1, 1), b3 + hstep, voffB);
            PG8_WAIT_V(6); PG8_BAR; PG8_MMA(1, 1, At, B1); PG8_BAR;
            }
        }
        if constexpr (ALIGN_EPI) { if (wr == 0) PG8_BAR; }
        if constexpr (!Epi::AFTER_DRAIN) { E(acc, cur, wr, wc, fr, fq); S.done(cur); }
        if (!has_next) break;
#pragma unroll
        for (int a = 0; a < 2; ++a)
#pragma unroll
            for (int b = 0; b < 2; ++b)
#pragma unroll
                for (int m = 0; m < 4; ++m)
#pragma unroll
                    for (int n = 0; n < 2; ++n) acc[a][b][m][n] = (f32x4){0.f, 0.f, 0.f, 0.f};
        cur = nxt; cA = nA; cB = nB; ++ui;
        if constexpr (ALIGN_EPI) { if (wr == 1) PG8_BAR; }
    }
    PG8_WAIT_V(0);
    if constexpr (!ALIGN_EPI) { if (wr == 0) PG8_BAR; }
    PG8_BAR;
    if constexpr (Epi::AFTER_DRAIN) { E.fused(acc, cur, wr, wc, fr, fq, lds, wid, lane); S.done(cur); }
#undef PG8_SA
#undef PG8_SB
#undef PG8_STAGE
#undef PG8_LDA
#undef PG8_LDB
#undef PG8_MMA
#undef PG8_WAIT_V
#undef PG8_WAIT_L
#undef PG8_BAR
#undef PG8_SCHED
}
}
#define GAS __attribute__((address_space(1)))
#define LAS __attribute__((address_space(3)))
typedef unsigned short bf16;
typedef unsigned v4u __attribute__((ext_vector_type(4)));
typedef float f32x4 __attribute__((ext_vector_type(4)));
typedef short bf16x8 __attribute__((ext_vector_type(8)));
typedef GAS unsigned gu32;
typedef GAS unsigned long long gu64;
#define RLX_AGENT __ATOMIC_RELAXED, __HIP_MEMORY_SCOPE_AGENT
#define LDS_WAIT() asm volatile("s_waitcnt lgkmcnt(0)" ::: "memory")
#define VM_WAIT() asm volatile("s_waitcnt vmcnt(0)" ::: "memory")
__device__ __forceinline__ unsigned long long rt() { return __builtin_amdgcn_s_memrealtime(); }
__device__ __forceinline__ unsigned f2bf(float f) { unsigned u = __builtin_bit_cast(unsigned, f); return (u + 0x7fffu + ((u >> 16) & 1u)) >> 16; }
__device__ __forceinline__ unsigned pk2(float lo, float hi) { return f2bf(lo) | (f2bf(hi) << 16); }
#define XB_TMO      128
#define XB_XCNT(j)  (256  + 64 * (j))
#define XB_XSUB(j)  (1280 + 64 * (j))
#define XB_XGEN(j)  (2304 + 64 * (j))
#define XB_TOP      3328
#define XB_TOPGEN   3392
#define XCD_BAR_WORDS 3456
#define XB_SPIN_CAP (1u << 18)

__device__ __forceinline__ unsigned xb_ld(unsigned* p)              { return __hip_atomic_load(p, __ATOMIC_RELAXED, __HIP_MEMORY_SCOPE_AGENT); }
__device__ __forceinline__ unsigned xb_add(unsigned* p, unsigned v) { return __hip_atomic_fetch_add(p, v, __ATOMIC_RELAXED, __HIP_MEMORY_SCOPE_AGENT); }
__device__ __forceinline__ unsigned xb_xcc_id() { return (unsigned)__builtin_amdgcn_s_getreg((3 << 11) | 20) & 0xFu; }
#define XB_SPIN(cond, bar) do { unsigned _sp = 0; while (cond) { __builtin_amdgcn_s_sleep(1); \
    if ((++_sp & 255u) == 0u) { if (xb_ld(&(bar)[XB_TMO])) break; if (_sp > XB_SPIN_CAP) { atomicAdd(&(bar)[XB_TMO], 1u); break; } } } } while (0)

struct XcdBarrier {
    unsigned* bar; unsigned x;
    volatile LAS unsigned* st;
};

__device__ __forceinline__ XcdBarrier xcd_barrier_post(unsigned* bar, volatile LAS unsigned* st) {
    XcdBarrier b; b.bar = bar; b.x = xb_xcc_id(); b.st = st;
    if (threadIdx.x == 0) (void)xb_add(&bar[XB_XCNT(b.x)], 1u);
    return b;
}
__device__ __forceinline__ void xcd_barrier_complete(unsigned* bar, unsigned x, unsigned& nloc, unsigned& nx) {
    const unsigned G = gridDim.x * gridDim.y * gridDim.z;
    unsigned sum, cnt, mine, sp = 0u;
    for (;;) {
        sum = 0u; cnt = 0u; mine = 0u;
#pragma unroll
        for (unsigned j = 0; j < 16; ++j) { const unsigned c = xb_ld(&bar[XB_XCNT(j)]); sum += c; cnt += (c > 0u) ? 1u : 0u; mine = (j == x) ? c : mine; }
        if (sum == G) break;
        __builtin_amdgcn_s_sleep(1);
        if ((++sp & 255u) == 0u) { if (xb_ld(&bar[XB_TMO])) break; if (sp > XB_SPIN_CAP) { atomicAdd(&bar[XB_TMO], 1u); break; } }
    }
    nloc = mine > 0u ? mine : 1u; nx = cnt > 0u ? cnt : 1u;
}

__device__ __forceinline__ void xcd_barrier(const XcdBarrier& b) {
    asm volatile("s_waitcnt vmcnt(0)" ::: "memory");
    __syncthreads();
    if (threadIdx.x == 0) {
        unsigned* bar = b.bar;
        __builtin_amdgcn_s_waitcnt(0);
        unsigned nloc = b.st[0], nx = b.st[1];
        if (nloc == 0u) { xcd_barrier_complete(bar, b.x, nloc, nx); b.st[0] = nloc; b.st[1] = nx; }
        const unsigned old = xb_add(&bar[XB_XSUB(b.x)], 1u);
        const unsigned gen = old / nloc;
        if (old + 1u == (gen + 1u) * nloc) {
            __builtin_amdgcn_fence(__ATOMIC_RELEASE, "agent");
            asm volatile("s_waitcnt vmcnt(0)" ::: "memory");
            const unsigned og = xb_add(&bar[XB_TOP], 1u);
            const unsigned tg = og / nx;
            if (og + 1u == (tg + 1u) * nx) xb_add(&bar[XB_TOPGEN], 1u);
            else XB_SPIN(xb_ld(&bar[XB_TOPGEN]) == tg, bar);
            __builtin_amdgcn_fence(__ATOMIC_ACQUIRE, "agent");
            xb_add(&bar[XB_XGEN(b.x)], 1u);
            asm volatile("s_waitcnt vmcnt(0)" ::: "memory");
        } else {
            XB_SPIN(xb_ld(&bar[XB_XGEN(b.x)]) == gen, bar);
            __builtin_amdgcn_fence(__ATOMIC_ACQUIRE, "agent");
            asm volatile("s_waitcnt vmcnt(0)" ::: "memory");
        }
    }
    __syncthreads();
}
constexpr int NWAVES = 8, NTHR = 512;
constexpr int D = 1024, SEQ = 8192, CTXL = 256, MLAT = 16384, MCTX = 512, MTOT = MLAT + MCTX, FF = 4096, NH = 16, HD = 64, KMIX = 1536;
constexpr float EPS = 1e-6f;
constexpr float QSCALE = 0.125f * 1.4426950408889634f;
constexpr float LOG2E = 1.4426950408889634f;
#ifndef TRIG_OFF
#define TRIG_OFF (1 * MiB + 256 * 1024)
#endif
#ifndef ARE_MIB
#define ARE_MIB 139
#endif
constexpr size_t MiB = 1u << 20;
constexpr size_t WS_CTL = 0, CTL_ZERO_BYTES = 1 * MiB;
constexpr size_t WS_MOD = 1 * MiB;
constexpr size_t WS_GAINS = 1 * MiB + 192 * 1024;
constexpr size_t WS_TRIG = TRIG_OFF;
constexpr size_t WS_WIN = 4 * MiB, WS_WOUT0 = 8 * MiB, WS_W1_0 = 12 * MiB, WS_W2_0 = 20 * MiB, WS_WQKV = 28 * MiB, WS_WOUT1 = 34 * MiB, WS_W1_1 = 36 * MiB, WS_W2_1 = 44 * MiB;
constexpr size_t WS_XN = 52 * MiB;
constexpr size_t WS_CTXS = 86 * MiB;
constexpr size_t WS_PB = 88 * MiB, WS_AB = 105 * MiB, WS_FB = 122 * MiB, WS_ARE = ARE_MIB * MiB, WS_AIM = (ARE_MIB + 16) * MiB, WS_MIXIN = 171 * MiB;
constexpr size_t WS_HB = 88 * MiB;
constexpr size_t WS_QB = 88 * MiB, WS_KB = 121 * MiB, WS_VB = 154 * MiB, WS_OB = 187 * MiB;
constexpr size_t WS_END = 256 * MiB;
static_assert(WS_MIXIN + (size_t)MTOT * KMIX * 2 <= WS_END && WS_HB + (size_t)MTOT * FF * 2 <= WS_END && WS_OB + (size_t)MLAT * D * 2 <= WS_END, "ws map");
constexpr int CW_BAR = 4096;
constexpr int RING_OFF = 0, RING_BYTES = 131072;
constexpr int LDS_BYTES = 163840;
constexpr int LDSCTL_OFF = LDS_BYTES - 512, MISC_OFF = LDSCTL_OFF + 320;

struct Ctx {
    LAS unsigned char* lds; int tid, lane, wave, gw, ngw, gt, ngt, G;
};

__device__ __forceinline__ float wave_sum(float v) {
#pragma unroll
    for (int o = 1; o < 64; o <<= 1) v += __shfl_xor(v, o);
    return v;
}
__device__ __forceinline__ float wave_max(float v) {
#pragma unroll
    for (int o = 1; o < 64; o <<= 1) v = fmaxf(v, __shfl_xor(v, o));
    return v;
}
__device__ __forceinline__ float bf2f(unsigned short h) { return __builtin_bit_cast(float, (unsigned)h << 16); }
__device__ __forceinline__ void unpack8(const v4u w, float (&f)[8]) {
    f[0] = __builtin_bit_cast(float, w.x << 16); f[1] = __builtin_bit_cast(float, w.x & 0xffff0000u);
    f[2] = __builtin_bit_cast(float, w.y << 16); f[3] = __builtin_bit_cast(float, w.y & 0xffff0000u);
    f[4] = __builtin_bit_cast(float, w.z << 16); f[5] = __builtin_bit_cast(float, w.z & 0xffff0000u);
    f[6] = __builtin_bit_cast(float, w.w << 16); f[7] = __builtin_bit_cast(float, w.w & 0xffff0000u);
}
__device__ __forceinline__ v4u pack8(const float (&f)[8]) { v4u o; o.x = pk2(f[0], f[1]); o.y = pk2(f[2], f[3]); o.z = pk2(f[4], f[5]); o.w = pk2(f[6], f[7]); return o; }

__device__ __forceinline__ int rowmap(int code, int n) {
    if (code == 1) {
        const int part = n >> 9, ch = n & 511, pn = ch >> 6, w = ch & 63, wc = w >> 4, fq = (w >> 2) & 3, e = w & 3, bj = part >> 1, nn = part & 1;
        return 256 * pn + 128 * bj + 32 * wc + 16 * nn + 4 * fq + e;
    }
    if (code == 2) {
        const int pn = n >> 8, w = n & 255, wc = w >> 6, bj = (w >> 5) & 1, x = w & 31;
        return 256 * pn + 128 * bj + 32 * wc + x;
    }
    return n;
}
__device__ __forceinline__ void transpose_item(const float* W, int N, bf16* WT, int KP, int koff, int code, LAS float* scr, int item, int lane) {
    const int nblk = N / 32, kb = item / nblk, nb = item % nblk, k0 = 64 * kb, n0 = 32 * nb;
#pragma unroll 8
    for (int i = 0; i < 32; ++i) { const int kk = 2 * i + (lane >> 5); scr[kk * 33 + (lane & 31)] = W[(size_t)(k0 + kk) * N + n0 + (lane & 31)]; }
    LDS_WAIT(); asm volatile("" ::: "memory");
    const int c = lane & 7;
#pragma unroll
    for (int j = 0; j < 4; ++j) { const int n = (lane >> 3) + 8 * j; const LAS float* s = scr + (8 * c) * 33 + n;
        v4u o; o.x = pk2(s[0 * 33], s[1 * 33]); o.y = pk2(s[2 * 33], s[3 * 33]); o.z = pk2(s[4 * 33], s[5 * 33]); o.w = pk2(s[6 * 33], s[7 * 33]);
        *(GAS v4u*)(WT + (size_t)rowmap(code, n0 + n) * KP + koff + k0 + 8 * c) = o; }
    LDS_WAIT(); asm volatile("" ::: "memory");
}
__device__ __forceinline__ void fold_item(const float* Wout, bf16* WT, LAS float* scr, const LAS float* tab, int item, int lane) {
    const int g = item >> 5, nb = item & 31, k0 = 512 + 64 * g, n0 = 32 * nb;
#pragma unroll 8
    for (int i = 0; i < 32; ++i) { const int kk = 2 * i + (lane >> 5); scr[kk * 33 + (lane & 31)] = Wout[(size_t)(k0 + kk) * 1024 + n0 + (lane & 31)]; }
    LDS_WAIT(); asm volatile("" ::: "memory");
    const int c8 = lane & 7;
    for (int j = 0; j < 4; ++j) { const int n = (lane >> 3) + 8 * j;
        float aP[8], aQ[8];
#pragma unroll
        for (int i = 0; i < 8; ++i) { aP[i] = 0.f; aQ[i] = 0.f; }
        for (int m = 0; m < 64; ++m) { const float x = scr[m * 33 + n];
#pragma unroll
            for (int i = 0; i < 8; ++i) { const int idx = ((8 * c8 + i) * m) & 63; aP[i] += tab[idx] * x; aQ[i] -= tab[64 + idx] * x; } }
        *(GAS v4u*)(WT + (size_t)(n0 + n) * KMIX + 512 + 64 * g + 8 * c8) = pack8(aP);
        *(GAS v4u*)(WT + (size_t)(n0 + n) * KMIX + 1024 + 64 * g + 8 * c8) = pack8(aQ); }
    LDS_WAIT(); asm volatile("" ::: "memory");
}

struct In { const float *x, *c, *ctx, *c_ctx, *ada_w, *ada_b, *nmix_g, *nmlp_g, *w1, *w2, *w_in, *conv_w, *w_out0, *w_qkv, *q_g, *k_g, *rpb, *w_out1; };

__device__ __forceinline__ void p0_prologue(const Ctx& F, const In& I, unsigned char* ws) {
    { float* trig = (float*)(ws + WS_TRIG); for (int j = F.gt; j < 8192; j += F.ngt) { trig[2 * j] = cospif((float)j * (1.0f / 4096.0f)); trig[2 * j + 1] = sinpif((float)j * (1.0f / 4096.0f)); } }
    if (F.gt < 128) ((float*)(ws + WS_GAINS))[F.gt] = F.gt < 64 ? I.q_g[F.gt] * QSCALE : I.k_g[F.gt - 64];
    if (blockIdx.x < 192) {
        LAS float* sc = (LAS float*)(F.lds);
        LAS float* red = (LAS float*)(F.lds + 12288);
        for (int i = F.tid; i < 3 * 1024; i += NTHR) { const int g = i >> 10, k = i & 1023; const float xv = g < 2 ? I.c[g * 1024 + k] : I.c_ctx[k]; sc[i] = xv / (1.0f + __expf(-xv)); }
        __syncthreads();
        const int layer = blockIdx.x / 96, cg = blockIdx.x % 96, col = cg * 64 + F.lane;
        const float* W = I.ada_w + (size_t)layer * 1024 * 6144 + col;
        float a0 = 0.f, a1 = 0.f, a2 = 0.f;
#pragma unroll 16
        for (int kk = 0; kk < 128; ++kk) { const int k = F.wave * 128 + kk; const float wv = W[(size_t)k * 6144]; a0 += sc[k] * wv; a1 += sc[1024 + k] * wv; a2 += sc[2048 + k] * wv; }
        red[(F.wave * 3 + 0) * 64 + F.lane] = a0; red[(F.wave * 3 + 1) * 64 + F.lane] = a1; red[(F.wave * 3 + 2) * 64 + F.lane] = a2;
        __syncthreads();
        if (F.wave < 3) { float s = I.ada_b[layer * 6144 + col];
#pragma unroll
            for (int w = 0; w < 8; ++w) s += red[(w * 3 + F.wave) * 64 + F.lane];
            ((float*)(ws + WS_MOD))[(layer * 3 + F.wave) * 6144 + col] = s; }
        __syncthreads();
    }
    LAS float* scr = (LAS float*)(F.lds + RING_OFF + F.wave * 16384);
    LAS float* tab = scr + 2112;
    tab[F.lane] = cospif((float)F.lane * (1.0f / 32.0f)); tab[64 + F.lane] = sinpif((float)F.lane * (1.0f / 32.0f));
    LDS_WAIT(); asm volatile("" ::: "memory");
    constexpr int I_WIN = 16 * 64, I_WO0 = 8 * 32, I_FOLD = 8 * 32, I_W1 = 16 * 128, I_W2 = 64 * 32, I_QKV = 16 * 96, I_WO1 = 16 * 32;
    constexpr int NITEMS = I_WIN + I_WO0 + I_FOLD + 2 * I_W1 + 2 * I_W2 + I_QKV + I_WO1;
    for (int it = F.gw; it < NITEMS; it += F.ngw) {
        int r = it;
        if (r < I_WIN) { transpose_item(I.w_in, 2048, (bf16*)(ws + WS_WIN), 1024, 0, 1, scr, r, F.lane); continue; } r -= I_WIN;
        if (r < I_WO0) { transpose_item(I.w_out0, 1024, (bf16*)(ws + WS_WOUT0), KMIX, 0, 0, scr, r, F.lane); continue; } r -= I_WO0;
        if (r < I_FOLD) { fold_item(I.w_out0, (bf16*)(ws + WS_WOUT0), scr, tab, r, F.lane); continue; } r -= I_FOLD;
        if (r < I_W1) { transpose_item(I.w1, 4096, (bf16*)(ws + WS_W1_0), 1024, 0, 0, scr, r, F.lane); continue; } r -= I_W1;
        if (r < I_W1) { transpose_item(I.w1 + (size_t)1024 * 4096, 4096, (bf16*)(ws + WS_W1_1), 1024, 0, 0, scr, r, F.lane); continue; } r -= I_W1;
        if (r < I_W2) { transpose_item(I.w2, 1024, (bf16*)(ws + WS_W2_0), 4096, 0, 0, scr, r, F.lane); continue; } r -= I_W2;
        if (r < I_W2) { transpose_item(I.w2 + (size_t)4096 * 1024, 1024, (bf16*)(ws + WS_W2_1), 4096, 0, 0, scr, r, F.lane); continue; } r -= I_W2;
        if (r < I_QKV) { transpose_item(I.w_qkv, 3072, (bf16*)(ws + WS_WQKV), 1024, 0, 2, scr, r, F.lane); continue; } r -= I_QKV;
        transpose_item(I.w_out1, 1024, (bf16*)(ws + WS_WOUT1), 1024, 0, 0, scr, r, F.lane);
    }
}

__device__ __forceinline__ void norm_phase(const Ctx& F, const float* lat, const float* ctx, int nrows, const float* gain, const float* mod, bf16* XN) {
    for (int m = F.gw; m < nrows; m += F.ngw) {
        const float* xrow = m < MLAT ? lat + (size_t)m * D : ctx + (size_t)(m - MLAT) * D;
        const int grp = m < SEQ ? 0 : (m < MLAT ? 1 : 2);
        const float* mg = mod + grp * 6144;
        const GAS f32x4* xr = (const GAS f32x4*)xrow + F.lane;
        f32x4 v[4]; float s = 0.f;
#pragma unroll
        for (int j = 0; j < 4; ++j) { v[j] = xr[64 * j]; s += (v[j].x * v[j].x + v[j].y * v[j].y) + (v[j].z * v[j].z + v[j].w * v[j].w); }
        const float rstd = rsqrtf(wave_sum(s) * (1.f / D) + EPS);
        GAS unsigned long long* o8 = (GAS unsigned long long*)(XN + (size_t)m * D) + F.lane;
#pragma unroll
        for (int j = 0; j < 4; ++j) { const int col = 4 * F.lane + 256 * j;
            const f32x4 gg = *(const f32x4*)(gain + col), sh = *(const f32x4*)(mg + col), sc = *(const f32x4*)(mg + 1024 + col);
            const f32x4 y = (v[j] * rstd) * gg * (sc + 1.0f) + sh;
            o8[64 * j] = (unsigned long long)pk2(y.x, y.y) | ((unsigned long long)pk2(y.z, y.w) << 32); }
    }
}

__device__ __forceinline__ void conv_phase(const Ctx& F, const bf16* PB, const bf16* AB, const float* cw, bf16* MIX) {
    for (int it = F.gt; it < MTOT * 64; it += F.ngt) {
        const int row = it >> 6, ch = (it & 63) * 8;
        int t, L; if (row < MLAT) { t = row & (SEQ - 1); L = SEQ; } else { t = (row - MLAT) & (CTXL - 1); L = CTXL; }
        float pc[8], pp[8], pn[8], ab[8], o[8];
        unpack8(*(const GAS v4u*)(PB + (size_t)row * 512 + ch), pc);
        unpack8(*(const GAS v4u*)(AB + (size_t)row * 512 + ch), ab);
        if (t > 0) unpack8(*(const GAS v4u*)(PB + (size_t)(row - 1) * 512 + ch), pp); else { for (int i = 0; i < 8; ++i) pp[i] = 0.f; }
        if (t < L - 1) unpack8(*(const GAS v4u*)(PB + (size_t)(row + 1) * 512 + ch), pn); else { for (int i = 0; i < 8; ++i) pn[i] = 0.f; }
#pragma unroll
        for (int i = 0; i < 8; ++i) o[i] = ab[i] * (cw[ch + i] * pp[i] + cw[512 + ch + i] * pc[i] + cw[1024 + ch + i] * pn[i]);
        *(GAS v4u*)(MIX + (size_t)row * KMIX + ch) = pack8(o);
    }
}
__device__ __forceinline__ void fft1_simple(const Ctx& F, const bf16* FB, const float* trig, bf16* ARE, bf16* AIM) {
    for (int it = F.gt; it < (1 << 20); it += F.ngt) {
        const int ch = (it & 63) * 8, t2 = (it >> 6) & 63, k1 = (it >> 12) & 127, b = it >> 19;
        float ar[8], ai[8];
#pragma unroll
        for (int i = 0; i < 8; ++i) { ar[i] = 0.f; ai[i] = 0.f; }
        for (int t1 = 0; t1 < 128; ++t1) {
            float x[8]; unpack8(*(const GAS v4u*)(FB + (size_t)(b * SEQ + 64 * t1 + t2) * 512 + ch), x);
            const int idx = (64 * k1 * t1) & 8191; const float c = trig[2 * idx], s = trig[2 * idx + 1];
#pragma unroll
            for (int i = 0; i < 8; ++i) { ar[i] += c * x[i]; ai[i] += s * x[i]; }
        }
        const int idx = (k1 * t2) & 8191; const float c = trig[2 * idx], s = trig[2 * idx + 1];
        float br[8], bi[8];
#pragma unroll
        for (int i = 0; i < 8; ++i) { br[i] = ar[i] * c - ai[i] * s; bi[i] = ar[i] * s + ai[i] * c; }
        const size_t off = ((size_t)(b * 128 + k1) * 64 + t2) * 512 + ch;
        *(GAS v4u*)(ARE + off) = pack8(br); *(GAS v4u*)(AIM + off) = pack8(bi);
    }
}
__device__ __forceinline__ void fftc_simple(const Ctx& F, const bf16* FB, const float* trig, bf16* MIX) {
    for (int it = F.gt; it < 2 * 256 * 64; it += F.ngt) {
        const int ch = (it & 63) * 8, k = (it >> 6) & 255, b = it >> 14;
        float p[8], q[8];
#pragma unroll
        for (int i = 0; i < 8; ++i) { p[i] = 0.f; q[i] = 0.f; }
        for (int t = 0; t < 256; ++t) {
            float x[8]; unpack8(*(const GAS v4u*)(FB + (size_t)(MLAT + b * 256 + t) * 512 + ch), x);
            const int idx = (32 * k * t) & 8191; const float c = trig[2 * idx], s = trig[2 * idx + 1];
#pragma unroll
            for (int i = 0; i < 8; ++i) { p[i] += c * x[i]; q[i] += s * x[i]; }
        }
#pragma unroll
        for (int i = 0; i < 8; ++i) { p[i] *= (1.0f / 128.0f); q[i] *= (1.0f / 128.0f); }
        const size_t off = (size_t)(MLAT + b * 256 + k) * KMIX + ch;
        *(GAS v4u*)(MIX + off + 512) = pack8(p); *(GAS v4u*)(MIX + off + 1024) = pack8(q);
    }
}
__device__ __forceinline__ void fft2_simple(const Ctx& F, const bf16* ARE, const bf16* AIM, const float* trig, bf16* MIX) {
    for (int it = F.gt; it < (1 << 20); it += F.ngt) {
        const int ch = (it & 63) * 8, k1 = (it >> 6) & 127, k2 = (it >> 13) & 63, b = it >> 19;
        float p[8], q[8];
#pragma unroll
        for (int i = 0; i < 8; ++i) { p[i] = 0.f; q[i] = 0.f; }
        for (int t2 = 0; t2 < 64; ++t2) {
            const size_t off = ((size_t)(b * 128 + k1) * 64 + t2) * 512 + ch;
            float br[8], bi[8]; unpack8(*(const GAS v4u*)(ARE + off), br); unpack8(*(const GAS v4u*)(AIM + off), bi);
            const int idx = (128 * k2 * t2) & 8191; const float c = trig[2 * idx], s = trig[2 * idx + 1];
#pragma unroll
            for (int i = 0; i < 8; ++i) { p[i] += c * br[i] - s * bi[i]; q[i] += s * br[i] + c * bi[i]; }
        }
        const float sc = 0.0013810679320049757f;
#pragma unroll
        for (int i = 0; i < 8; ++i) { p[i] *= sc; q[i] *= sc; }
        const size_t off = (size_t)(b * SEQ + k1 + 128 * k2) * KMIX + ch;
        *(GAS v4u*)(MIX + off + 512) = pack8(p); *(GAS v4u*)(MIX + off + 1024) = pack8(q);
    }
}
__device__ __forceinline__ void na_simple(const Ctx& F, const bf16* QB, const bf16* KB, const bf16* VB, const float* rpb, bf16* OB) {
    LAS float* pbuf = (LAS float*)(F.lds + F.wave * 16384);
    for (int task = F.gw; task < MLAT * NH; task += F.ngw) {
        const int h = task & 15, row = task >> 4, b = row >> 13, t = row & 8191, r = t >> 6, c = t & 63;
        const int rs = min(max(r - 4, 0), 120), cs = min(max(c - 8, 0), 48);
        float q[64];
#pragma unroll
        for (int i = 0; i < 8; ++i) { float tmp[8]; unpack8(*(const GAS v4u*)(QB + (size_t)row * D + h * 64 + 8 * i), tmp);
#pragma unroll
            for (int e = 0; e < 8; ++e) q[8 * i + e] = tmp[e]; }
        float sv[6]; float mx = -3.0e38f;
#pragma unroll
        for (int i = 0; i < 6; ++i) { const int j = F.lane + 64 * i; size_t krow; float bias = 0.f;
            if (j < 128) { const int rr = rs + (j >> 4), cc = cs + (j & 15); krow = (size_t)b * SEQ + rr * 64 + cc; bias = rpb[(h * 15 + (rr - r + 7)) * 31 + (cc - c + 15)] * LOG2E; }
            else krow = (size_t)MLAT + b * 256 + (j - 128);
            float dot = 0.f;
#pragma unroll
            for (int i8 = 0; i8 < 8; ++i8) { float kk[8]; unpack8(*(const GAS v4u*)(KB + krow * D + h * 64 + 8 * i8), kk);
#pragma unroll
                for (int e = 0; e < 8; ++e) dot += q[8 * i8 + e] * kk[e]; }
            sv[i] = dot + bias; mx = fmaxf(mx, sv[i]); }
        mx = wave_max(mx);
        float l = 0.f;
#pragma unroll
        for (int i = 0; i < 6; ++i) { const float p = exp2f(sv[i] - mx); l += p; pbuf[F.lane + 64 * i] = p; }
        l = wave_sum(l);
        LDS_WAIT(); asm volatile("" ::: "memory");
        float o = 0.f;
        for (int j = 0; j < 384; ++j) { size_t krow;
            if (j < 128) krow = (size_t)b * SEQ + (rs + (j >> 4)) * 64 + cs + (j & 15); else krow = (size_t)MLAT + b * 256 + (j - 128);
            o += pbuf[j] * bf2f(VB[krow * D + h * 64 + F.lane]); }
        OB[(size_t)row * D + h * 64 + F.lane] = (bf16)f2bf(o / l);
        LDS_WAIT(); asm volatile("" ::: "memory");
    }
}
typedef short v4i16_t __attribute__((ext_vector_type(4)));
constexpr int NA_KC = 0, NA_VC = 32768, NA_RING = 65536, NA_NSLOT = 11, NA_TAB = NA_RING + NA_NSLOT * 8192;
__device__ __forceinline__ int na_rs(int r) { return min(max(r - 4, 0), 120); }
#if PROBE
#define NA_T() __builtin_amdgcn_s_memrealtime()
#else
#define NA_T() 0ull
#endif
__device__ __forceinline__ void na_fast(const Ctx& F, const bf16* QB, const bf16* KB, const bf16* VB, const bf16* KBC, const bf16* VBC, const float* rpb, bf16* OB, void* na_ts = nullptr) {
    LAS unsigned char* lds = F.lds;
    const int lane = F.lane, w = F.wave, i = lane & 15, g = lane >> 4, q_ = i >> 2, p_ = i & 3;
    unsigned long long tq0 = 0, tq1 = 0, tq2 = 0, tq3 = 0, tq4 = 0, tlast = NA_T();
#define NA_MARK(acc) do { const unsigned long long _t = NA_T(); acc += _t - tlast; tlast = _t; } while (0)
    for (int sw = F.gw >> 3; sw < 256; sw += F.G) {
        const int bh = sw >> 3, b = bh >> 4, h = bh & 15, band = sw & 7;
        for (int id = F.tid; id < 2048; id += NTHR) { const int key = id >> 3, c = id & 7; const size_t src = (size_t)(b * 256 + key) * D + h * 64 + c * 8;
            const v4u kv = *(const GAS v4u*)(KBC + src), vv = *(const GAS v4u*)(VBC + src);
            *(LAS v4u*)(lds + NA_KC + key * 128 + ((c ^ ((key >> 1) & 7)) << 4)) = kv;
            *(LAS v4u*)(lds + NA_VC + key * 128 + ((c ^ (((key >> 1) & 3) << 1)) << 4)) = vv; }
        for (int j = F.tid; j < 465; j += NTHR) ((LAS float*)(lds + NA_TAB))[j] = rpb[h * 465 + j] * LOG2E;
        const bf16* Vbh = VB + (size_t)b * SEQ * D + h * 64;
#define NA_DMA_ROWS(rlo, rhi) do { const int _n = ((rhi) - (rlo)) * 8; for (int _p = w; _p < _n; _p += NWAVES) { const int _rr = (rlo) + (_p >> 3), _j = _p & 7, _col = 8 * _j + (lane >> 3), _c = (lane & 7) ^ (((_col >> 1) & 3) << 1); \
            __builtin_amdgcn_global_load_lds((const unsigned*)(Vbh + (size_t)(_rr * 64 + _col) * D + _c * 8), (LAS unsigned*)(lds + NA_RING + (_rr % NA_NSLOT) * 8192 + _j * 1024), 16, 0, 0); } } while (0)
        { const int r0 = 16 * band; const int lo = na_rs(r0), hi = na_rs(r0 + 1) + 8; NA_DMA_ROWS(lo, hi); }
        asm volatile("s_waitcnt vmcnt(0)" ::: "memory"); __syncthreads();
        NA_MARK(tq0);
        for (int pi = 0; pi < 8; ++pi) {
            const int r0 = 16 * band + 2 * pi;
            if (pi < 7) { const int hi = na_rs(r0 + 1) + 8, nhi = na_rs(r0 + 3) + 8; NA_DMA_ROWS(hi, nhi); }
            const int r = r0 + (w >> 2), c0 = 16 * (w & 3), u0 = min(max(c0 - 8, 0), 32), rs_ = na_rs(r);
            const bf16* qp = QB + (size_t)(b * SEQ + r * 64 + c0 + i) * D + h * 64 + 16 * g;
            const bf16x8 qf0 = *(const GAS bf16x8*)qp, qf1 = *(const GAS bf16x8*)(qp + 8);
            f32x4 S[32];
            const bf16* kp = KB + (size_t)(b * SEQ + rs_ * 64 + u0 + i) * D + h * 64 + 16 * g;
            {
                bf16x8 kf[16][2];
#pragma unroll
                for (int T = 0; T < 16; ++T) { const bf16* kt = kp + (size_t)((T >> 1) * 64 + 16 * (T & 1)) * D; kf[T][0] = *(const GAS bf16x8*)kt; kf[T][1] = *(const GAS bf16x8*)(kt + 8); }
                __builtin_amdgcn_sched_barrier(0);
#if PROBE
                asm volatile("s_waitcnt vmcnt(0)" ::: "memory"); NA_MARK(tq1);
#endif
#pragma unroll
                for (int T = 0; T < 16; ++T) { f32x4 acc = __builtin_amdgcn_mfma_f32_16x16x32_bf16(kf[T][0], qf0, (f32x4){0.f, 0.f, 0.f, 0.f}, 0, 0, 0);
                    S[T] = __builtin_amdgcn_mfma_f32_16x16x32_bf16(kf[T][1], qf1, acc, 0, 0, 0); }
            }
#pragma unroll
            for (int T4 = 0; T4 < 16; T4 += 4) { bf16x8 cf[4][2];
#pragma unroll
                for (int u = 0; u < 4; ++u) { const int key = 16 * (T4 + u) + i, x = (key >> 1) & 7;
                    cf[u][0] = *(const LAS bf16x8*)(lds + NA_KC + key * 128 + (((2 * g) ^ x) << 4)); cf[u][1] = *(const LAS bf16x8*)(lds + NA_KC + key * 128 + (((2 * g + 1) ^ x) << 4)); }
#pragma unroll
                for (int u = 0; u < 4; ++u) { f32x4 acc = __builtin_amdgcn_mfma_f32_16x16x32_bf16(cf[u][0], qf0, (f32x4){0.f, 0.f, 0.f, 0.f}, 0, 0, 0);
                    S[16 + T4 + u] = __builtin_amdgcn_mfma_f32_16x16x32_bf16(cf[u][1], qf1, acc, 0, 0, 0); } }
            { const int c = c0 + i, cs = min(max(c - 8, 0), 48); const LAS float* tab = (const LAS float*)(lds + NA_TAB);
#pragma unroll
              for (int T = 0; T < 16; ++T) { const int ro = (rs_ + (T >> 1)) - r + 7;
#pragma unroll
                for (int e = 0; e < 4; ++e) { const int cc = u0 + 16 * (T & 1) + 4 * g + e; const bool ok = (unsigned)(cc - cs) < 16u; float bv = tab[ro * 31 + cc - c + 15]; asm volatile("" : "+v"(bv));
                    S[T][e] = ok ? S[T][e] + bv : -1.0e30f; } } }
            float mx = -3.0e38f;
#pragma unroll
            for (int T = 0; T < 32; ++T) mx = fmaxf(fmaxf(mx, fmaxf(S[T][0], S[T][1])), fmaxf(S[T][2], S[T][3]));
            mx = fmaxf(mx, __shfl_xor(mx, 16)); mx = fmaxf(mx, __shfl_xor(mx, 32));
            float l = 0.f;
#pragma unroll
            for (int T = 0; T < 32; ++T) {
#pragma unroll
                for (int e = 0; e < 4; ++e) { S[T][e] = __builtin_amdgcn_exp2f(S[T][e] - mx); l += S[T][e]; } }
            l += __shfl_xor(l, 16); l += __shfl_xor(l, 32);
#if PROBE
            asm volatile("" : "+v"(l)); NA_MARK(tq2);
#endif
            f32x4 O[4];
#pragma unroll
            for (int m = 0; m < 4; ++m) O[m] = (f32x4){0.f, 0.f, 0.f, 0.f};
            const int swz = ((2 * g + (q_ >> 1)) & 3) << 1;
            int voff[4];
#pragma unroll
            for (int m = 0; m < 4; ++m) voff[m] = (((2 * m + (p_ >> 1)) ^ swz) << 4) + (p_ & 1) * 8;
            bf16x8 va[2][4];
#define NA_VLOAD(t, dst) do { int rowb_; if ((t) < 8) rowb_ = NA_RING + ((rs_ + (t)) % NA_NSLOT) * 8192 + (u0 + 4 * g + q_) * 128; else rowb_ = NA_VC + (32 * ((t) - 8) + 4 * g + q_) * 128; \
                _Pragma("unroll") for (int m = 0; m < 4; ++m) { \
                    const v4i16_t v0 = __builtin_amdgcn_ds_read_tr16_b64_v4i16((LAS v4i16_t*)(lds + rowb_ + voff[m])); \
                    const v4i16_t v1 = __builtin_amdgcn_ds_read_tr16_b64_v4i16((LAS v4i16_t*)(lds + rowb_ + 2048 + voff[m])); \
                    dst[m] = (bf16x8){v0[0], v0[1], v0[2], v0[3], v1[0], v1[1], v1[2], v1[3]}; } } while (0)
            NA_VLOAD(0, va[0]);
#pragma unroll
            for (int t = 0; t < 16; ++t) {
                if (t + 1 < 16) NA_VLOAD(t + 1, va[(t + 1) & 1]);
                v4u pw; pw.x = pg8::cvt_pk_bf16(S[2 * t][0], S[2 * t][1]); pw.y = pg8::cvt_pk_bf16(S[2 * t][2], S[2 * t][3]); pw.z = pg8::cvt_pk_bf16(S[2 * t + 1][0], S[2 * t + 1][1]); pw.w = pg8::cvt_pk_bf16(S[2 * t + 1][2], S[2 * t + 1][3]);
                const bf16x8 pb = __builtin_bit_cast(bf16x8, pw);
#pragma unroll
                for (int m = 0; m < 4; ++m) O[m] = __builtin_amdgcn_mfma_f32_16x16x32_bf16(va[t & 1][m], pb, O[m], 0, 0, 0);
            }
#undef NA_VLOAD
            const float rl = 1.0f / l;
            bf16* op = OB + (size_t)(b * SEQ + r * 64 + c0 + i) * D + h * 64 + 4 * g;
#pragma unroll
            for (int m = 0; m < 4; ++m) { pg8::u32x2 o2; o2.x = pg8::cvt_pk_bf16(O[m][0] * rl, O[m][1] * rl); o2.y = pg8::cvt_pk_bf16(O[m][2] * rl, O[m][3] * rl); *(GAS pg8::u32x2*)(op + 16 * m) = o2; }
#if PROBE
            NA_MARK(tq3);
#endif
            asm volatile("s_waitcnt vmcnt(0)" ::: "memory"); __syncthreads();
#if PROBE
            NA_MARK(tq4);
#endif
        }
#undef NA_DMA_ROWS
    }
#if PROBE
    if (blockIdx.x == 0 && F.tid == 0) { unsigned long long* TSX = (unsigned long long*)na_ts; TSX[0] = tq0; TSX[1] = tq1; TSX[2] = tq2; TSX[3] = tq3; TSX[4] = tq4; }
#endif
}
__device__ __forceinline__ void na_fast2(const Ctx& F, const bf16* QB, const bf16* KB, const bf16* VB, const bf16* KBC, const bf16* VBC, const float* rpb, bf16* OB) {
    LAS unsigned char* lds = F.lds;
    const int lane = F.lane, w = F.wave, i = lane & 15, g = lane >> 4, q_ = i >> 2, p_ = i & 3;
    const int swz = ((2 * g + (q_ >> 1)) & 3) << 1;
    int voff[4];
#pragma unroll
    for (int m = 0; m < 4; ++m) voff[m] = (((2 * m + (p_ >> 1)) ^ swz) << 4) + (p_ & 1) * 8;
    const int c0 = 16 * (w & 3), u0 = min(max(c0 - 8, 0), 32), c = c0 + i, cs = min(max(c - 8, 0), 48);
    const LAS float* tab = (const LAS float*)(lds + NA_TAB);
    for (int sw = F.gw >> 3; sw < 256; sw += F.G) {
        const int bh = sw >> 3, b = bh >> 4, h = bh & 15, band = sw & 7;
        for (int id = F.tid; id < 2048; id += NTHR) { const int key = id >> 3, cc = id & 7; const size_t src = (size_t)(b * 256 + key) * D + h * 64 + cc * 8;
            const v4u kv = *(const GAS v4u*)(KBC + src), vv = *(const GAS v4u*)(VBC + src);
            *(LAS v4u*)(lds + NA_KC + key * 128 + ((cc ^ ((key >> 1) & 7)) << 4)) = kv;
            *(LAS v4u*)(lds + NA_VC + key * 128 + ((cc ^ (((key >> 1) & 3) << 1)) << 4)) = vv; }
        for (int j = F.tid; j < 465; j += NTHR) ((LAS float*)(lds + NA_TAB))[j] = rpb[h * 465 + j] * LOG2E;
        const bf16* Vbh = VB + (size_t)b * SEQ * D + h * 64;
        const bf16* Kbh = KB + (size_t)b * SEQ * D + h * 64 + 16 * g;
#define NA_DMA_ROWS(rlo, rhi) do { const int _n = ((rhi) - (rlo)) * 8; for (int _p = w; _p < _n; _p += NWAVES) { const int _rr = (rlo) + (_p >> 3), _j = _p & 7, _col = 8 * _j + (lane >> 3), _c = (lane & 7) ^ (((_col >> 1) & 3) << 1); \
            __builtin_amdgcn_global_load_lds((const unsigned*)(Vbh + (size_t)(_rr * 64 + _col) * D + _c * 8), (LAS unsigned*)(lds + NA_RING + (_rr % NA_NSLOT) * 8192 + _j * 1024), 16, 0, 0); } } while (0)
#define NA_KLOAD(dst, rsv, T0) do { const bf16* _kp = Kbh + (size_t)((rsv) * 64 + u0 + i) * D; _Pragma("unroll") for (int _T = 0; _T < 8; ++_T) { const bf16* _kt = _kp + (size_t)((((T0) + _T) >> 1) * 64 + 16 * (_T & 1)) * D; dst[_T][0] = *(const GAS bf16x8*)_kt; dst[_T][1] = *(const GAS bf16x8*)(_kt + 8); } } while (0)
        { const int r0 = 16 * band; const int lo = na_rs(r0), hi = na_rs(r0 + 1) + 8; NA_DMA_ROWS(lo, hi); }
        bf16x8 kfA[8][2], kfB[8][2];
        NA_KLOAD(kfA, na_rs(16 * band + (w >> 2)), 0);
        asm volatile("s_waitcnt vmcnt(0)" ::: "memory"); __syncthreads();
        for (int pi = 0; pi < 8; ++pi) {
            const int r0 = 16 * band + 2 * pi;
            const int r = r0 + (w >> 2), rs_ = na_rs(r);
            const bf16* qp = QB + (size_t)(b * SEQ + r * 64 + c0 + i) * D + h * 64 + 16 * g;
            const bf16x8 qf0 = *(const GAS bf16x8*)qp, qf1 = *(const GAS bf16x8*)(qp + 8);
            f32x4 O[4]; float l = 0.f;
#pragma unroll
            for (int m = 0; m < 4; ++m) O[m] = (f32x4){0.f, 0.f, 0.f, 0.f};
            bf16x8 va[2][4];
#define NA_VLOAD(t, dst) do { int rowb_; if ((t) < 8) rowb_ = NA_RING + ((rs_ + (t)) % NA_NSLOT) * 8192 + (u0 + 4 * g + q_) * 128; else rowb_ = NA_VC + (32 * ((t) - 8) + 4 * g + q_) * 128; \
                _Pragma("unroll") for (int m = 0; m < 4; ++m) { \
                    const v4i16_t v0 = __builtin_amdgcn_ds_read_tr16_b64_v4i16((LAS v4i16_t*)(lds + rowb_ + voff[m])); \
                    const v4i16_t v1 = __builtin_amdgcn_ds_read_tr16_b64_v4i16((LAS v4i16_t*)(lds + rowb_ + 2048 + voff[m])); \
                    dst[m] = (bf16x8){v0[0], v0[1], v0[2], v0[3], v1[0], v1[1], v1[2], v1[3]}; } } while (0)
#define NA_CHUNK_PV(S, t0) do { \
                _Pragma("unroll") for (int T = 0; T < 8; ++T) { _Pragma("unroll") for (int e = 0; e < 4; ++e) { S[T][e] = __builtin_amdgcn_exp2f(S[T][e]); l += S[T][e]; } } \
                _Pragma("unroll") for (int tt = 0; tt < 4; ++tt) { NA_VLOAD((t0) + tt, va[tt & 1]); \
                    v4u pw; pw.x = pg8::cvt_pk_bf16(S[2 * tt][0], S[2 * tt][1]); pw.y = pg8::cvt_pk_bf16(S[2 * tt][2], S[2 * tt][3]); pw.z = pg8::cvt_pk_bf16(S[2 * tt + 1][0], S[2 * tt + 1][1]); pw.w = pg8::cvt_pk_bf16(S[2 * tt + 1][2], S[2 * tt + 1][3]); \
                    const bf16x8 pb = __builtin_bit_cast(bf16x8, pw); \
                    _Pragma("unroll") for (int m = 0; m < 4; ++m) O[m] = __builtin_amdgcn_mfma_f32_16x16x32_bf16(va[tt & 1][m], pb, O[m], 0, 0, 0); } } while (0)
#define NA_BIAS(S, T0) do { _Pragma("unroll") for (int T = 0; T < 8; ++T) { const int ro = (rs_ + (((T0) + T) >> 1)) - r + 7; \
                _Pragma("unroll") for (int e = 0; e < 4; ++e) { const int cc = u0 + 16 * (T & 1) + 4 * g + e; const bool ok = (unsigned)(cc - cs) < 16u; float bv = tab[ro * 31 + cc - c + 15]; asm volatile("" : "+v"(bv)); S[T][e] = ok ? bv : -1.0e30f; } } } while (0)
            {
                f32x4 S[8]; NA_BIAS(S, 0);
#pragma unroll
                for (int T = 0; T < 8; ++T) { S[T] = __builtin_amdgcn_mfma_f32_16x16x32_bf16(kfA[T][0], qf0, S[T], 0, 0, 0); S[T] = __builtin_amdgcn_mfma_f32_16x16x32_bf16(kfA[T][1], qf1, S[T], 0, 0, 0); }
                NA_KLOAD(kfB, rs_, 8);
                NA_CHUNK_PV(S, 0);
            }
            {
                f32x4 S[8]; NA_BIAS(S, 8);
#pragma unroll
                for (int T = 0; T < 8; ++T) { S[T] = __builtin_amdgcn_mfma_f32_16x16x32_bf16(kfB[T][0], qf0, S[T], 0, 0, 0); S[T] = __builtin_amdgcn_mfma_f32_16x16x32_bf16(kfB[T][1], qf1, S[T], 0, 0, 0); }
                if (pi < 7) { const int hi = na_rs(r0 + 1) + 8, nhi = na_rs(r0 + 3) + 8; NA_DMA_ROWS(hi, nhi);
                    NA_KLOAD(kfA, na_rs(r + 2), 0); }
                NA_CHUNK_PV(S, 4);
            }
#pragma unroll
            for (int cc2 = 0; cc2 < 2; ++cc2) {
                f32x4 S[8];
#pragma unroll
                for (int T = 0; T < 8; ++T) { const int key = 128 * cc2 + 16 * T + i, x = (key >> 1) & 7;
                    const bf16x8 a0 = *(const LAS bf16x8*)(lds + NA_KC + key * 128 + (((2 * g) ^ x) << 4)), a1 = *(const LAS bf16x8*)(lds + NA_KC + key * 128 + (((2 * g + 1) ^ x) << 4));
                    S[T] = __builtin_amdgcn_mfma_f32_16x16x32_bf16(a0, qf0, (f32x4){0.f, 0.f, 0.f, 0.f}, 0, 0, 0); S[T] = __builtin_amdgcn_mfma_f32_16x16x32_bf16(a1, qf1, S[T], 0, 0, 0); }
                NA_CHUNK_PV(S, 8 + 4 * cc2);
            }
            l += __shfl_xor(l, 16); l += __shfl_xor(l, 32);
            const float rl = 1.0f / l;
            bf16* op = OB + (size_t)(b * SEQ + r * 64 + c0 + i) * D + h * 64 + 4 * g;
#pragma unroll
            for (int m = 0; m < 4; ++m) { pg8::u32x2 o2; o2.x = pg8::cvt_pk_bf16(O[m][0] * rl, O[m][1] * rl); o2.y = pg8::cvt_pk_bf16(O[m][2] * rl, O[m][3] * rl); *(GAS pg8::u32x2*)(op + 16 * m) = o2; }
            asm volatile("s_waitcnt vmcnt(0)" ::: "memory"); __syncthreads();
        }
#undef NA_DMA_ROWS
#undef NA_KLOAD
#undef NA_VLOAD
#undef NA_CHUNK_PV
#undef NA_BIAS
    }
}
#ifndef DFT_X1
#define DFT_X1 0
#endif
#ifndef DFT_X3
#define DFT_X3 0
#endif
constexpr size_t WS_T1C = 2 * MiB, WS_T1S = WS_T1C + 32768, WS_T2C = WS_T1C + 65536, WS_T2S = WS_T2C + 8192, WS_T3C = 2 * MiB + 131072, WS_T3S = WS_T3C + 131072;
__device__ __forceinline__ void build_dft_tables(const Ctx& F, unsigned char* ws) {
    bf16* t1c = (bf16*)(ws + WS_T1C); bf16* t1s = (bf16*)(ws + WS_T1S); bf16* t2c = (bf16*)(ws + WS_T2C); bf16* t2s = (bf16*)(ws + WS_T2S); bf16* t3c = (bf16*)(ws + WS_T3C); bf16* t3s = (bf16*)(ws + WS_T3S);
    for (int j = F.gt; j < 16384 + 4096 + 65536; j += F.ngt) {
        if (j < 16384) { const int k = j >> 7, t = j & 127; const float a = (float)((k * t) & 127) * (1.0f / 64.0f); t1c[j] = (bf16)f2bf(cospif(a)); t1s[j] = (bf16)f2bf(sinpif(a)); }
        else if (j < 16384 + 4096) { const int jj = j - 16384, k = jj >> 6, t = jj & 63; const float a = (float)((k * t) & 63) * (1.0f / 32.0f); t2c[jj] = (bf16)f2bf(cospif(a)); t2s[jj] = (bf16)f2bf(sinpif(a)); }
        else { const int jj = j - 16384 - 4096, k = jj >> 8, t = jj & 255; const float a = (float)((k * t) & 255) * (1.0f / 128.0f); t3c[jj] = (bf16)f2bf(cospif(a)); t3s[jj] = (bf16)f2bf(sinpif(a)); }
    }
}
__device__ __forceinline__ int dft_h(int row) { return ((row & 3) | (((row >> 3) & 1) << 2)) << 1; }
template <int ROWB> __device__ __forceinline__ void dft_load_tile(LAS unsigned char* lds, int xoff, const bf16* src0, size_t rstride, int nrows, int wave, int lane) {
    constexpr int RPP = 1024 / ROWB, CPR = ROWB / 16; const int pieces = nrows / RPP;
#if DFT_NO_DMA
    for (int p = wave; p < pieces; p += NWAVES) { const int row = p * RPP + lane / CPR, c = (lane % CPR) ^ dft_h(row);
        const v4u v = *(const GAS v4u*)(src0 + (size_t)row * rstride + c * 8); *(LAS v4u*)(lds + xoff + p * 1024 + lane * 16) = v; }
#else
    for (int p = wave; p < pieces; p += NWAVES) { const int row = p * RPP + lane / CPR, c = (lane % CPR) ^ dft_h(row);
        __builtin_amdgcn_global_load_lds((const unsigned*)(src0 + (size_t)row * rstride + c * 8), (LAS unsigned*)(lds + xoff + p * 1024), 16, 0, 0); }
#endif
}
template <int T_LEN> __device__ __forceinline__ void dft_load_table(LAS unsigned char* lds, int toff, const bf16* tab, int nk, int tid) {
    constexpr int CPR = T_LEN / 8, TP = T_LEN * 2 + 16;
    for (int id = tid; id < nk * CPR; id += NTHR) { const int row = id / CPR, c = id % CPR; *(LAS v4u*)(lds + toff + row * TP + c * 16) = *(const GAS v4u*)(tab + (size_t)row * T_LEN + c * 8); }
}
typedef short v4i16_t2 __attribute__((ext_vector_type(4)));
__device__ __forceinline__ bf16x8 dft_afrag(LAS unsigned char* lds, int addr0, int addr1) {
    const v4i16_t2 v0 = __builtin_amdgcn_ds_read_tr16_b64_v4i16((LAS v4i16_t2*)(lds + addr0)), v1 = __builtin_amdgcn_ds_read_tr16_b64_v4i16((LAS v4i16_t2*)(lds + addr1));
    return (bf16x8){v0[0], v0[1], v0[2], v0[3], v1[0], v1[1], v1[2], v1[3]};
}
template <int T_LEN, int ROWB, int MT, int NT>
__device__ __forceinline__ void dft_real_core(LAS unsigned char* lds, int xoff, int tcoff, int tsoff, int wave, int lane, int nt0, f32x4 (&accC)[MT][NT], f32x4 (&accS)[MT][NT], const bf16* gtc = nullptr, const bf16* gts = nullptr) {
    constexpr int TP = T_LEN * 2 + 16;
    const int i = lane & 15, g = lane >> 4, q_ = i >> 2, p_ = i & 3, h = (q_ | ((g & 1) << 2)) << 1;
#pragma unroll
    for (int mt = 0; mt < MT; ++mt)
#pragma unroll
        for (int nt = 0; nt < NT; ++nt) { accC[mt][nt] = (f32x4){0.f, 0.f, 0.f, 0.f}; accS[mt][nt] = (f32x4){0.f, 0.f, 0.f, 0.f}; }
#pragma unroll
    for (int s = 0; s < T_LEN / 32; ++s) {
        bf16x8 A[MT];
#pragma unroll
        for (int mt = 0; mt < MT; ++mt) { const int c = (16 * MT * wave + 16 * mt) / 8 + (p_ >> 1); const int row0 = 32 * s + 8 * g + q_;
            const int a0 = xoff + row0 * ROWB + ((c ^ h) << 4) + (p_ & 1) * 8; A[mt] = dft_afrag(lds, a0, a0 + 4 * ROWB); }
#pragma unroll
        for (int nt = 0; nt < NT; ++nt) { const int boff = (16 * (nt0 + nt) + i) * TP + (32 * s + 8 * g) * 2;
#if DFT_X1
            const bf16x8 bc = *(const GAS bf16x8*)(gtc + (size_t)(16 * (nt0 + nt) + i) * T_LEN + 32 * s + 8 * g), bs = *(const GAS bf16x8*)(gts + (size_t)(16 * (nt0 + nt) + i) * T_LEN + 32 * s + 8 * g);
#else
            const bf16x8 bc = *(const LAS bf16x8*)(lds + tcoff + boff), bs = *(const LAS bf16x8*)(lds + tsoff + boff);
#endif
#pragma unroll
            for (int mt = 0; mt < MT; ++mt) { accC[mt][nt] = __builtin_amdgcn_mfma_f32_16x16x32_bf16(A[mt], bc, accC[mt][nt], 0, 0, 0); accS[mt][nt] = __builtin_amdgcn_mfma_f32_16x16x32_bf16(A[mt], bs, accS[mt][nt], 0, 0, 0); } }
    }
}
__device__ __forceinline__ void st4(bf16* p, const f32x4 v) { pg8::u32x2 w; w.x = pg8::cvt_pk_bf16(v[0], v[1]); w.y = pg8::cvt_pk_bf16(v[2], v[3]); *(GAS pg8::u32x2*)p = w; }
#ifndef DFT_X1
#define DFT_X1 0
#endif
#ifndef DFT_X3
#define DFT_X3 0
#endif
#ifndef S1NT
#define S1NT 4
#endif
constexpr int DFT_X = 0, DFT_X2 = 32768, DFT_TC = 65536, DFT_TS = DFT_TC + 34816;

__device__ __forceinline__ void fft1_fast(const Ctx& F, const bf16* FB, const float* trig, const unsigned char* ws, bf16* ARE, bf16* AIM, bf16* MIX) {
    LAS unsigned char* lds = F.lds; const int lane = F.lane, w = F.wave, i = lane & 15, g = lane >> 4;
    bool tables = false;
#if !FFTL_SIMPLE
    for (int task = F.gw >> 3; task < 256; task += F.G) {
        const int b = task >> 7, t2 = (task >> 1) & 63, half = task & 1;
        if (!tables) { dft_load_table<128>(lds, DFT_TC, (const bf16*)(ws + WS_T1C), 128, F.tid); dft_load_table<128>(lds, DFT_TS, (const bf16*)(ws + WS_T1S), 128, F.tid); tables = true; }
        dft_load_tile<512>(lds, DFT_X, FB + (size_t)(b * SEQ + t2) * 512 + half * 256, (size_t)64 * 512, 128, w, lane);
        asm volatile("s_waitcnt vmcnt(0)" ::: "memory"); __syncthreads();
        for (int pass = 0; pass < 8 / S1NT; ++pass) {
        f32x4 aC[2][S1NT], aS[2][S1NT];
        dft_real_core<128, 512, 2, S1NT>(lds, DFT_X, DFT_TC, DFT_TS, w, lane, S1NT * pass, aC, aS, (const bf16*)(ws + WS_T1C), (const bf16*)(ws + WS_T1S));
#pragma unroll
        for (int nt = 0; nt < S1NT; ++nt) { const int k1 = 16 * (S1NT * pass + nt) + i, idx = (k1 * t2) & 8191;
#if DFT_X3
            const float c = cospif((float)idx * (1.0f / 4096.0f)), s = sinpif((float)idx * (1.0f / 4096.0f));
#else
            const float c = trig[2 * idx], s = trig[2 * idx + 1];
#endif
            const size_t off = ((size_t)(b * 128 + k1) * 64 + t2) * 512 + half * 256 + 32 * w + 4 * g;
#pragma unroll
            for (int mt = 0; mt < 2; ++mt) { st4(ARE + off + 16 * mt, aC[mt][nt] * c - aS[mt][nt] * s); st4(AIM + off + 16 * mt, aC[mt][nt] * s + aS[mt][nt] * c); } }
        }
        __syncthreads();
    }
#endif
#if !FFTC_SIMPLE
    for (int task = F.gw >> 3; task < 32; task += F.G) {
        const int b = task >> 4, cq = (task >> 2) & 3, kb = task & 3;
        __syncthreads();
        dft_load_table<256>(lds, DFT_TC, (const bf16*)(ws + WS_T3C) + (size_t)kb * 64 * 256, 64, F.tid); dft_load_table<256>(lds, DFT_TS, (const bf16*)(ws + WS_T3S) + (size_t)kb * 64 * 256, 64, F.tid);
        dft_load_tile<256>(lds, DFT_X, FB + (size_t)(MLAT + b * 256) * 512 + cq * 128, (size_t)512, 256, w, lane);
        asm volatile("s_waitcnt vmcnt(0)" ::: "memory"); __syncthreads();
        f32x4 aC[1][4], aS[1][4];
        dft_real_core<256, 256, 1, 4>(lds, DFT_X, DFT_TC, DFT_TS, w, lane, 0, aC, aS);
#pragma unroll
        for (int nt = 0; nt < 4; ++nt) { const int k = 64 * kb + 16 * nt + i; const size_t off = (size_t)(MLAT + b * 256 + k) * KMIX + cq * 128 + 16 * w + 4 * g;
            st4(MIX + off + 512, aC[0][nt] * (1.0f / 128.0f)); st4(MIX + off + 1024, aS[0][nt] * (1.0f / 128.0f)); }
        __syncthreads();
    }
#endif
}
__device__ __forceinline__ void fft2_fast(const Ctx& F, const bf16* ARE, const bf16* AIM, const unsigned char* ws, bf16* MIX) {
    LAS unsigned char* lds = F.lds; const int lane = F.lane, w = F.wave, i = lane & 15, g = lane >> 4, q_ = i >> 2, p_ = i & 3, h = (q_ | ((g & 1) << 2)) << 1;
    constexpr int TP = 64 * 2 + 16;
    bool tables = false;
    for (int task = F.gw >> 3; task < 512; task += F.G) {
        const int b = task >> 8, k1 = (task >> 1) & 127, half = task & 1;
        if (!tables) { dft_load_table<64>(lds, DFT_TC, (const bf16*)(ws + WS_T2C), 64, F.tid); dft_load_table<64>(lds, DFT_TS, (const bf16*)(ws + WS_T2S), 64, F.tid); tables = true; }
        const size_t src = (size_t)(b * 128 + k1) * 64 * 512 + half * 256;
        dft_load_tile<512>(lds, DFT_X, ARE + src, (size_t)512, 64, w, lane); dft_load_tile<512>(lds, DFT_X2, AIM + src, (size_t)512, 64, w, lane);
        asm volatile("s_waitcnt vmcnt(0)" ::: "memory"); __syncthreads();
        f32x4 aP[2][4], aQ[2][4];
#pragma unroll
        for (int mt = 0; mt < 2; ++mt)
#pragma unroll
            for (int nt = 0; nt < 4; ++nt) { aP[mt][nt] = (f32x4){0.f, 0.f, 0.f, 0.f}; aQ[mt][nt] = (f32x4){0.f, 0.f, 0.f, 0.f}; }
#pragma unroll
        for (int s = 0; s < 2; ++s) {
            bf16x8 Ar[2], Ai[2];
#pragma unroll
            for (int mt = 0; mt < 2; ++mt) { const int c = (32 * w + 16 * mt) / 8 + (p_ >> 1); const int row0 = 32 * s + 8 * g + q_;
                const int a0 = row0 * 512 + ((c ^ h) << 4) + (p_ & 1) * 8; Ar[mt] = dft_afrag(lds, DFT_X + a0, DFT_X + a0 + 2048); Ai[mt] = dft_afrag(lds, DFT_X2 + a0, DFT_X2 + a0 + 2048); }
#pragma unroll
            for (int nt = 0; nt < 4; ++nt) { const int boff = (16 * nt + i) * TP + (32 * s + 8 * g) * 2;
                const bf16x8 bc = *(const LAS bf16x8*)(lds + DFT_TC + boff), bs = *(const LAS bf16x8*)(lds + DFT_TS + boff);
                const bf16x8 bns = __builtin_bit_cast(bf16x8, __builtin_bit_cast(v4u, bs) ^ 0x80008000u);
#pragma unroll
                for (int mt = 0; mt < 2; ++mt) {
                    aP[mt][nt] = __builtin_amdgcn_mfma_f32_16x16x32_bf16(Ar[mt], bc, aP[mt][nt], 0, 0, 0); aP[mt][nt] = __builtin_amdgcn_mfma_f32_16x16x32_bf16(Ai[mt], bns, aP[mt][nt], 0, 0, 0);
                    aQ[mt][nt] = __builtin_amdgcn_mfma_f32_16x16x32_bf16(Ar[mt], bs, aQ[mt][nt], 0, 0, 0); aQ[mt][nt] = __builtin_amdgcn_mfma_f32_16x16x32_bf16(Ai[mt], bc, aQ[mt][nt], 0, 0, 0); } }
        }
        const float sc = 0.0013810679320049757f;
#pragma unroll
        for (int nt = 0; nt < 4; ++nt) { const int k2 = 16 * nt + i; const size_t off = (size_t)(b * SEQ + k1 + 128 * k2) * KMIX + half * 256 + 32 * w + 4 * g;
#pragma unroll
            for (int mt = 0; mt < 2; ++mt) { st4(MIX + off + 512 + 16 * mt, aP[mt][nt] * sc); st4(MIX + off + 1024 + 16 * mt, aQ[mt][nt] * sc); } }
        __syncthreads();
    }
}
constexpr int CG_A = 0, CG_B = 34816, CG_O = 69632, CG_RS = CG_O + 17408, CG_AB = CG_RS + 256, CG_PITCH = 272, CG_OP = 68;
constexpr size_t WS_HBC = 221 * MiB, WS_KBC = 225 * MiB, WS_VBC = 226 * MiB;
template <int AMODE, int EPI>
__device__ __forceinline__ void ctx_gemm(const Ctx& F, const bf16* A, int lda, const float* Ares, const float* gain, const float* mod, const bf16* Bt, int K, int ntn, int code,
                                         bf16* o0, bf16* o1, bf16* o2, size_t ostride, const float* rin, float* rout, const float* gate, const float* kgain) {
    LAS unsigned char* lds = F.lds; const int tid = F.tid, lane = F.lane, w = F.wave, i = lane & 15, g = lane >> 4, wm = w >> 2, wn = w & 3;
    const int r_ld = tid >> 3, kc = (tid & 7) * 16;
    LAS float* O = (LAS float*)(lds + CG_O); LAS float* rs = (LAS float*)(lds + CG_RS); LAS float* ab = (LAS float*)(lds + CG_AB);
    if (AMODE == 1) { for (int k = tid; k < 1024; k += NTHR) { ab[2 * k] = gain[k] * (1.0f + mod[1024 + k]); ab[2 * k + 1] = mod[k]; } }
    for (int t = F.gw >> 3; t < 8 * ntn; t += F.G) {
        const int mt = t / ntn, nt = t % ntn, row0 = 64 * mt;
        __syncthreads();
        if (AMODE == 1) {
            for (int jj = 0; jj < 8; ++jj) { const GAS f32x4* xr = (const GAS f32x4*)(Ares + (size_t)(row0 + 8 * w + jj) * 1024) + lane; float s = 0.f;
#pragma unroll
                for (int j = 0; j < 4; ++j) { const f32x4 v = xr[64 * j]; s += (v.x * v.x + v.y * v.y) + (v.z * v.z + v.w * v.w); }
                s = wave_sum(s); if (lane == 0) rs[8 * w + jj] = rsqrtf(s * (1.0f / 1024.0f) + EPS); }
            __syncthreads();
        }
        int brow;
        if (code == 1) brow = rowmap(1, ((r_ld >> 4) << 9) + 16 * nt + (r_ld & 15)); else if (code == 2) brow = rowmap(2, 1024 + 64 * nt + r_ld); else brow = 64 * nt + r_ld;
        const bf16* bp = Bt + (size_t)brow * K + kc;
        const bf16* ap = A + (size_t)(row0 + r_ld) * lda + kc;
        const float* xp = Ares + (size_t)(row0 + r_ld) * 1024 + kc;
        v4u a0, a1, b0, b1; f32x4 x0, x1, x2, x3;
        if (AMODE == 0) { a0 = *(const GAS v4u*)ap; a1 = *(const GAS v4u*)(ap + 8); } else { x0 = *(const GAS f32x4*)xp; x1 = *(const GAS f32x4*)(xp + 4); x2 = *(const GAS f32x4*)(xp + 8); x3 = *(const GAS f32x4*)(xp + 12); }
        b0 = *(const GAS v4u*)bp; b1 = *(const GAS v4u*)(bp + 8);
        f32x4 acc[2]; acc[0] = (f32x4){0.f, 0.f, 0.f, 0.f}; acc[1] = (f32x4){0.f, 0.f, 0.f, 0.f};
        const int nch = K >> 7;
        for (int c = 0; c < nch; ++c) {
            const int buf = (c & 1) * 17408;
            LAS unsigned char* wa = lds + CG_A + buf + r_ld * CG_PITCH + kc * 2; LAS unsigned char* wb = lds + CG_B + buf + r_ld * CG_PITCH + kc * 2;
            if (AMODE == 0) { *(LAS v4u*)wa = a0; *(LAS v4u*)(wa + 16) = a1; }
            else { const float rr = rs[r_ld]; const LAS float* abk = ab + 2 * (c * 128 + kc); float y[16];
#pragma unroll
                for (int e = 0; e < 4; ++e) { y[e] = x0[e] * rr * abk[2 * e] + abk[2 * e + 1]; y[4 + e] = x1[e] * rr * abk[8 + 2 * e] + abk[9 + 2 * e]; y[8 + e] = x2[e] * rr * abk[16 + 2 * e] + abk[17 + 2 * e]; y[12 + e] = x3[e] * rr * abk[24 + 2 * e] + abk[25 + 2 * e]; }
                v4u p0, p1; p0.x = pk2(y[0], y[1]); p0.y = pk2(y[2], y[3]); p0.z = pk2(y[4], y[5]); p0.w = pk2(y[6], y[7]); p1.x = pk2(y[8], y[9]); p1.y = pk2(y[10], y[11]); p1.z = pk2(y[12], y[13]); p1.w = pk2(y[14], y[15]);
                *(LAS v4u*)wa = p0; *(LAS v4u*)(wa + 16) = p1; }
            *(LAS v4u*)wb = b0; *(LAS v4u*)(wb + 16) = b1;
            if (c + 1 < nch) { const int ko = (c + 1) * 128;
                if (AMODE == 0) { a0 = *(const GAS v4u*)(ap + ko); a1 = *(const GAS v4u*)(ap + ko + 8); } else { x0 = *(const GAS f32x4*)(xp + ko); x1 = *(const GAS f32x4*)(xp + ko + 4); x2 = *(const GAS f32x4*)(xp + ko + 8); x3 = *(const GAS f32x4*)(xp + ko + 12); }
                b0 = *(const GAS v4u*)(bp + ko); b1 = *(const GAS v4u*)(bp + ko + 8); }
            __syncthreads();
#pragma unroll
            for (int s = 0; s < 4; ++s) { const bf16x8 bf = *(const LAS bf16x8*)(lds + CG_B + buf + (16 * wn + i) * CG_PITCH + (32 * s + 8 * g) * 2);
#pragma unroll
                for (int m = 0; m < 2; ++m) { const bf16x8 af = *(const LAS bf16x8*)(lds + CG_A + buf + (32 * wm + 16 * m + i) * CG_PITCH + (32 * s + 8 * g) * 2);
                    acc[m] = __builtin_amdgcn_mfma_f32_16x16x32_bf16(af, bf, acc[m], 0, 0, 0); } }
        }
#pragma unroll
        for (int m = 0; m < 2; ++m)
#pragma unroll
            for (int e = 0; e < 4; ++e) O[(32 * wm + 16 * m + 4 * g + e) * CG_OP + 16 * wn + i] = acc[m][e];
        __syncthreads();
        const int r = tid >> 3;
        if (EPI == 0) { const int cq = tid & 7; const LAS float* orow = O + r * CG_OP + 2 * cq;
            const float ax0 = orow[0], ax1 = orow[1], ac0 = orow[16], ac1 = orow[17], ab0 = orow[32], ab1 = orow[33], f0 = orow[48], f1 = orow[49];
            const size_t off = (size_t)(MLAT + row0 + r) * 512 + 16 * nt + 2 * cq;
            *(GAS unsigned*)(o0 + off) = pk2(ax0 * ac0, ax1 * ac1); *(GAS unsigned*)(o1 + off) = pk2(ab0, ab1); *(GAS unsigned*)(o2 + off) = pk2(f0, f1);
        } else { const int c8 = (tid & 7) * 8; const f32x4 v0 = *(const LAS f32x4*)(O + r * CG_OP + c8), v1 = *(const LAS f32x4*)(O + r * CG_OP + c8 + 4);
            if (EPI == 1) { const size_t off = (size_t)(row0 + r) * 1024 + 64 * nt + c8; const f32x4 g0 = *(const f32x4*)(gate + 64 * nt + c8), g1 = *(const f32x4*)(gate + 64 * nt + c8 + 4);
                const f32x4 r0 = *(const GAS f32x4*)(rin + off), r1 = *(const GAS f32x4*)(rin + off + 4); *(GAS f32x4*)(rout + off) = r0 + g0 * v0; *(GAS f32x4*)(rout + off + 4) = r1 + g1 * v1; }
            if (EPI == 2) { float y[8];
#pragma unroll
                for (int e = 0; e < 4; ++e) { const float a = fmaxf(v0[e], 0.f), b = fmaxf(v1[e], 0.f); y[e] = a * a; y[4 + e] = b * b; }
                *(GAS v4u*)(o0 + (size_t)(row0 + r) * 4096 + 64 * nt + c8) = pack8(y); }
            if (EPI == 3) { const int part = nt >> 4, hh = nt & 15; float y[8];
#pragma unroll
                for (int e = 0; e < 4; ++e) { y[e] = v0[e]; y[4 + e] = v1[e]; }
                float ss = 0.f;
#pragma unroll
                for (int e = 0; e < 8; ++e) ss += y[e] * y[e];
                ss += __shfl_xor(ss, 1); ss += __shfl_xor(ss, 2); ss += __shfl_xor(ss, 4);
                const float rstd = rsqrtf(ss * (1.0f / 64.0f) + EPS);
                if (part == 0) {
#pragma unroll
                    for (int e = 0; e < 8; ++e) y[e] = y[e] * rstd * kgain[c8 + e]; }
                *(GAS v4u*)(o0 + (size_t)part * ostride + (size_t)(row0 + r) * 1024 + hh * 64 + c8) = pack8(y); }
        }
    }
    __syncthreads();
}
#ifndef FFTC_SIMPLE
#define FFTC_SIMPLE 0
#endif
#ifndef DFT_NO_DMA
#define DFT_NO_DMA 0
#endif
#ifndef FFTL_PRE
#define FFTL_PRE 0
#endif
#ifndef FFTL_BOTH
#define FFTL_BOTH 0
#endif
#ifndef FFTL_SIMPLE
#define FFTL_SIMPLE 0
#endif
#ifndef FFT1_SIMPLE
#define FFT1_SIMPLE 0
#endif
#ifndef FFT2_SIMPLE
#define FFT2_SIMPLE 0
#endif
#ifndef NA_SIMPLE
#define NA_SIMPLE 0
#endif
#ifndef PROBE
#define PROBE 0
#endif
#ifndef PROBE_A
#define PROBE_A 0
#endif
#ifndef PROBE_B
#define PROBE_B 1
#endif
#ifndef MK_MULTI
#define MK_MULTI 0
#endif
constexpr int NPHASE = 16;
struct Args { const float* in[18]; float* out; unsigned char* ws; int ph_lo, ph_hi; };
__global__ void __launch_bounds__(NTHR, 2) hyb_fwd(Args args) {
    extern __shared__ __attribute__((aligned(16))) unsigned char lds_raw[];
    Ctx F; F.lds = (LAS unsigned char*)lds_raw; F.tid = threadIdx.x; F.lane = F.tid & 63; F.wave = __builtin_amdgcn_readfirstlane(F.tid >> 6); F.G = gridDim.x;
    { const int bx = blockIdx.x; const int vcu = (F.G % 8 == 0) ? (bx % 8) * (F.G / 8) + bx / 8 : bx;
      F.gw = vcu * NWAVES + F.wave; F.ngw = F.G * NWAVES; F.gt = vcu * NTHR + F.tid; F.ngt = F.G * NTHR; }
    unsigned char* ws = args.ws;
    In I; I.x = args.in[0]; I.c = args.in[1]; I.ctx = args.in[2]; I.c_ctx = args.in[3]; I.ada_w = args.in[4]; I.ada_b = args.in[5]; I.nmix_g = args.in[6]; I.nmlp_g = args.in[7];
    I.w1 = args.in[8]; I.w2 = args.in[9]; I.w_in = args.in[10]; I.conv_w = args.in[11]; I.w_out0 = args.in[12]; I.w_qkv = args.in[13]; I.q_g = args.in[14]; I.k_g = args.in[15]; I.rpb = args.in[16]; I.w_out1 = args.in[17];
    float* out = args.out;
    for (int u = F.tid; u < (LDS_BYTES - LDSCTL_OFF) / 4; u += NTHR) ((LAS unsigned*)(F.lds + LDSCTL_OFF))[u] = 0u;
    __syncthreads();
    XcdBarrier bar; bar.bar = (unsigned*)(ws + WS_CTL) + CW_BAR; bar.x = 0; bar.st = nullptr;
    if (!MK_MULTI) bar = xcd_barrier_post((unsigned*)(ws + WS_CTL) + CW_BAR, (volatile LAS unsigned*)(F.lds + MISC_OFF) + 8);
    const int lo = args.ph_lo, hi = args.ph_hi;
#define IN(k) (lo <= (k) && (k) < hi)
#if PROBE
    unsigned long long* TS = (unsigned long long*)(ws + WS_CTL + 512 * 1024);
    if (blockIdx.x == 0 && F.tid == 0) TS[0] = __builtin_amdgcn_s_memrealtime();
#define SEAM(k) do { if (IN(k) && IN((k) + 1)) { xcd_barrier(bar); if (blockIdx.x == 0 && F.tid == 0) TS[(k) + 1] = __builtin_amdgcn_s_memrealtime(); } } while (0)
#else
#define SEAM(k) do { if (IN(k) && IN((k) + 1)) xcd_barrier(bar); } while (0)
#endif
    const float* MOD = (const float*)(ws + WS_MOD);
    const float* trig = (const float*)(ws + WS_TRIG);
    bf16* XN = (bf16*)(ws + WS_XN); float* CTXS = (float*)(ws + WS_CTXS);
    bf16 *PB = (bf16*)(ws + WS_PB), *AB = (bf16*)(ws + WS_AB), *FB = (bf16*)(ws + WS_FB), *ARE = (bf16*)(ws + WS_ARE), *AIM = (bf16*)(ws + WS_AIM), *MIX = (bf16*)(ws + WS_MIXIN);
    bf16 *HB = (bf16*)(ws + WS_HB), *QB = (bf16*)(ws + WS_QB), *KB = (bf16*)(ws + WS_KB), *VB = (bf16*)(ws + WS_VB), *OB = (bf16*)(ws + WS_OB);
    LAS unsigned char* ring = F.lds + RING_OFF;
    const int bid = (int)blockIdx.x;

    bf16 *HBC = (bf16*)(ws + WS_HBC), *KBC = (bf16*)(ws + WS_KBC);
    const float* MODC0 = MOD + 2 * 6144;
    const float* MODC1 = MOD + 18432 + 2 * 6144;
    if (IN(0)) { build_dft_tables(F, ws); p0_prologue(F, I, ws); } SEAM(0);
    if (IN(1)) { norm_phase(F, I.x, I.ctx, MLAT, I.nmix_g, MOD, XN); } SEAM(1);
    if (IN(2)) { pg8::Gemm g{XN, (const bf16*)(ws + WS_WIN), MLAT, 2048, 1024}; pg8::StaticOrder S; S.init(MLAT, 2048, F.G, bid);
        pg8::EpiWin E{PB, AB, FB}; pg8::gemm_phase<pg8::EpiWin, pg8::StaticOrder, true, true>(ring, g, S, E);
        ctx_gemm<1, 0>(F, nullptr, 0, I.ctx, I.nmix_g, MODC0, (const bf16*)(ws + WS_WIN), 1024, 32, 1, PB, AB, FB, 0, nullptr, nullptr, nullptr, nullptr); } SEAM(2);
    if (IN(3)) { fft1_fast(F, FB, trig, ws, ARE, AIM, MIX); conv_phase(F, PB, AB, I.conv_w, MIX); } SEAM(3);
    if (IN(4)) { fft2_fast(F, ARE, AIM, ws, MIX);
        ctx_gemm<0, 1>(F, MIX + (size_t)MLAT * KMIX, KMIX, nullptr, nullptr, nullptr, (const bf16*)(ws + WS_WOUT0), KMIX, 16, 0, nullptr, nullptr, nullptr, 0, I.ctx, CTXS, MODC0 + 2048, nullptr); } SEAM(4);
    if (IN(5)) { pg8::Gemm g{MIX, (const bf16*)(ws + WS_WOUT0), MLAT, 1024, KMIX}; pg8::StaticOrder S; S.init(MLAT, 1024, F.G, bid);
        pg8::EpiRes E{I.x, I.ctx, out, CTXS, MOD + 2048}; pg8::gemm_phase<pg8::EpiRes, pg8::StaticOrder, true, true>(ring, g, S, E);
        ctx_gemm<1, 2>(F, nullptr, 0, CTXS, I.nmlp_g, MODC0 + 3072, (const bf16*)(ws + WS_W1_0), 1024, 64, 0, HBC, nullptr, nullptr, 0, nullptr, nullptr, nullptr, nullptr); } SEAM(5);
    if (IN(6)) { norm_phase(F, out, CTXS, MLAT, I.nmlp_g, MOD + 3072, XN);
        ctx_gemm<0, 1>(F, HBC, FF, nullptr, nullptr, nullptr, (const bf16*)(ws + WS_W2_0), FF, 16, 0, nullptr, nullptr, nullptr, 0, CTXS, CTXS, MODC0 + 5120, nullptr); } SEAM(6);
    if (IN(7)) { pg8::Gemm g{XN, (const bf16*)(ws + WS_W1_0), MLAT, FF, 1024}; pg8::StaticOrder S; S.init(MLAT, FF, F.G, bid);
        pg8::EpiRelu2 E{HB, FF}; pg8::gemm_phase<pg8::EpiRelu2, pg8::StaticOrder, true, true>(ring, g, S, E);
        ctx_gemm<1, 3>(F, nullptr, 0, CTXS, I.nmix_g + 1024, MODC1, (const bf16*)(ws + WS_WQKV), 1024, 32, 2, KBC, nullptr, nullptr, (size_t)(WS_VBC - WS_KBC) / 2, nullptr, nullptr, nullptr, (const float*)(ws + WS_GAINS) + 64); } SEAM(7);
    if (IN(8)) { pg8::Gemm g{HB, (const bf16*)(ws + WS_W2_0), MLAT, 1024, FF}; pg8::StaticOrder S; S.init(MLAT, 1024, F.G, bid);
        pg8::EpiRes E{out, CTXS, out, CTXS, MOD + 5120}; pg8::gemm_phase<pg8::EpiRes, pg8::StaticOrder, true, true>(ring, g, S, E); } SEAM(8);
    if (IN(9)) { norm_phase(F, out, CTXS, MLAT, I.nmix_g + 1024, MOD + 18432, XN); } SEAM(9);
    if (IN(10)) { pg8::Gemm g{XN, (const bf16*)(ws + WS_WQKV), MLAT, 3072, 1024}; pg8::StaticOrder S; S.init(MLAT, 3072, F.G, bid);
        pg8::EpiQkv E{QB, (size_t)(WS_KB - WS_QB) / 2, (const float*)(ws + WS_GAINS)}; pg8::gemm_phase<pg8::EpiQkv, pg8::StaticOrder, true, true>(ring, g, S, E); } SEAM(10);
    if (IN(11)) { na_fast2(F, QB, KB, VB, KBC, KBC + (size_t)(WS_VBC - WS_KBC) / 2, I.rpb, OB); } SEAM(11);
    if (IN(12)) { pg8::Gemm g{OB, (const bf16*)(ws + WS_WOUT1), MLAT, 1024, 1024}; pg8::StaticOrder S; S.init(MLAT, 1024, F.G, bid);
        pg8::EpiRes E{out, CTXS, out, CTXS, MOD + 18432 + 2048}; pg8::gemm_phase<pg8::EpiRes, pg8::StaticOrder, true, true>(ring, g, S, E); } SEAM(12);
    if (IN(13)) { norm_phase(F, out, CTXS, MLAT, I.nmlp_g + 1024, MOD + 18432 + 3072, XN); } SEAM(13);
    if (IN(14)) { pg8::Gemm g{XN, (const bf16*)(ws + WS_W1_1), MLAT, FF, 1024}; pg8::StaticOrder S; S.init(MLAT, FF, F.G, bid);
        pg8::EpiRelu2 E{HB, FF}; pg8::gemm_phase<pg8::EpiRelu2, pg8::StaticOrder, true, true>(ring, g, S, E); } SEAM(14);
    if (IN(15)) { pg8::Gemm g{HB, (const bf16*)(ws + WS_W2_1), MLAT, 1024, FF}; pg8::StaticOrder S; S.init(MLAT, 1024, F.G, bid);
        pg8::EpiRes E{out, CTXS, out, CTXS, MOD + 18432 + 5120}; pg8::gemm_phase<pg8::EpiRes, pg8::StaticOrder, true, true>(ring, g, S, E); }
#if PROBE
    if (blockIdx.x == 0 && F.tid == 0) { const unsigned long long t16 = __builtin_amdgcn_s_memrealtime(); const unsigned long long d = (PROBE_A >= 100 ? ((unsigned long long*)(ws + WS_CTL + 768 * 1024))[PROBE_A - 100] : (TS[PROBE_A + 1] - TS[PROBE_A])) * 8ull;
        while (__builtin_amdgcn_s_memrealtime() - t16 < d) __builtin_amdgcn_s_sleep(8); }
#endif
#undef IN
#undef SEAM
}

extern "C" void kernel_launch(void* const* d_in, const int* in_sizes, int n_in, void* d_out, int out_size, void* d_ws, size_t ws_size, hipStream_t stream) {
    static int grid = 0;
    if (grid == 0) {
        if (n_in != 18 || out_size != MLAT * D || ws_size < WS_END) { fprintf(stderr, "kernel_launch: unexpected shapes (n_in %d out %d ws %zu)\n", n_in, out_size, ws_size); grid = -1; return; }
        int dev = 0, cus = 0;
        if (hipGetDevice(&dev) != hipSuccess || hipDeviceGetAttribute(&cus, hipDeviceAttributeMultiprocessorCount, dev) != hipSuccess) { grid = -1; return; }
        if (hipFuncSetAttribute((const void*)hyb_fwd, hipFuncAttributeMaxDynamicSharedMemorySize, LDS_BYTES) != hipSuccess) { fprintf(stderr, "kernel_launch: hipFuncSetAttribute failed\n"); grid = -1; return; }
        (void)hipGetLastError();
        grid = cus;
    }
    if (grid < 0) return;
    if (hipMemsetAsync((char*)d_ws + WS_CTL, 0, CTL_ZERO_BYTES, stream) != hipSuccess) return;
    Args a{};
    for (int i = 0; i < 18; ++i) a.in[i] = (const float*)d_in[i];
    a.out = (float*)d_out; a.ws = (unsigned char*)d_ws;
#if MK_MULTI
    for (int p = 0; p < NPHASE; ++p) { a.ph_lo = p; a.ph_hi = p + 1; hipLaunchKernelGGL(hyb_fwd, dim3(grid), dim3(NTHR), LDS_BYTES, stream, a); }
#else
    a.ph_lo = 0; a.ph_hi = NPHASE; hipLaunchKernelGGL(hyb_fwd, dim3(grid), dim3(NTHR), LDS_BYTES, stream, a);
#endif
}
```
